# Optimizing an MI355X kernel written in HIP

```python
import math
import jax, jax.numpy as jnp
from jax import lax
import numpy as np

D_MODEL = 1024
BATCH = 4
SEQ = 4096
DEPTH = 1
DEC_BATCH = 32
DEC_SEQ = 8
PAST_LEN = 8192
PAGE_SIZE = 128

MIX_WIDTH = D_MODEL
A_HEADS = 4
A_DK = 128
A_DV = 128
A_WIDTH = A_HEADS * A_DV
CONV_W = 4
DELTA_CHUNK = 64
CONV_DIM = 2 * A_HEADS * A_DK + A_HEADS * A_DV
B_HEAD_DIM = 64
B_WIDTH = MIX_WIDTH - A_WIDTH
B_HEADS = B_WIDTH // B_HEAD_DIM
DILATED = ((128, 1), (512, 4), (2048, 16))
MAX_WINDOW = 2048
D_FF = ((8 * D_MODEL // 3 + 255) // 256) * 256
EPS = 1e-6
NEG = -1e30
IN_COLS = CONV_DIM + A_WIDTH + 2 * A_HEADS + 3 * B_WIDTH
SPLITS = (CONV_DIM, CONV_DIM + A_WIDTH, CONV_DIM + A_WIDTH + A_HEADS, CONV_DIM + A_WIDTH + 2 * A_HEADS)

kernel_name = "hymba_gdn_dilated_swa_decode_step"


def rmsnorm(x, w):
    xf = x.astype(jnp.float32)
    y = xf * lax.rsqrt(jnp.mean(xf * xf, axis=-1, keepdims=True) + EPS)
    return (y * w.astype(jnp.float32)).astype(x.dtype)


def l2norm(x):
    return x * lax.rsqrt(jnp.sum(x * x, axis=-1, keepdims=True) + EPS)


def alibi_slopes():
    return 2.0 ** (-8.0 * jnp.arange(1, B_HEADS + 1, dtype=jnp.float32) / B_HEADS)


def causal_conv(u, buf, w):
    ext = jnp.concatenate([buf.astype(u.dtype), u], axis=1)
    T = u.shape[1]
    out = sum(ext[:, i:i + T] * w[i] for i in range(CONV_W))
    return jax.nn.silu(out), ext[:, ext.shape[1] - (CONV_W - 1):]


def gated_delta_rule(q, k, v, g, beta, s0):
    B, T, H, DK = q.shape
    DV = v.shape[-1]
    C = min(DELTA_CHUNK, T)
    Tp = -(-T // C) * C
    pad = Tp - T
    if pad:
        pw = ((0, 0), (0, pad), (0, 0), (0, 0))
        q, k, v = jnp.pad(q, pw), jnp.pad(k, pw), jnp.pad(v, pw)
        g, beta = jnp.pad(g, pw[:3]), jnp.pad(beta, pw[:3])
    N = Tp // C

    def chunks(a):
        a = a.reshape((B, N, C, H) + a.shape[3:])
        return jnp.moveaxis(a, (1, 3), (0, 2))

    qc, kc, vc, bc = chunks(q), chunks(k), chunks(v), chunks(beta)
    gc = jnp.cumsum(chunks(g), axis=-1)
    idx = jnp.arange(C)
    incl = idx[:, None] >= idx[None, :]
    strict = idx[:, None] > idx[None, :]
    decay = jnp.exp(jnp.where(incl, gc[..., :, None] - gc[..., None, :], -jnp.inf))
    kb = kc * bc[..., None]
    lower = jnp.where(strict, jnp.einsum('nbhcd,nbhsd->nbhcs', kb, kc) * decay, 0.0)
    eye = jnp.eye(C, dtype=jnp.float32)
    t_inv = lax.linalg.triangular_solve(eye + lower, jnp.broadcast_to(eye, lower.shape),
                                        left_side=True, lower=True, unit_diagonal=True)
    u = t_inv @ (vc * bc[..., None])
    w = t_inv @ (kb * jnp.exp(gc)[..., None])
    qk = jnp.einsum('nbhcd,nbhsd->nbhcs', qc, kc) * decay
    g_last = gc[..., -1]

    def step(S, xs):
        q_i, k_i, u_i, w_i, qk_i, g_i, gl_i = xs
        e = u_i - jnp.einsum('bhcd,bhde->bhce', w_i, S)
        o = (jnp.einsum('bhcd,bhde->bhce', q_i * jnp.exp(g_i)[..., None], S)
             + jnp.einsum('bhcs,bhse->bhce', qk_i, e))
        S = (S * jnp.exp(gl_i)[..., None, None]
             + jnp.einsum('bhcd,bhce->bhde', k_i * jnp.exp(gl_i[..., None] - g_i)[..., None], e))
        return S, o

    s_final, o = lax.scan(step, s0, (qc, kc, u, w, qk, gc, g_last))
    o = jnp.moveaxis(o, (0, 2), (1, 3)).reshape(B, Tp, H, DV)[:, :T]
    return o, s_final


def dilated_branch_prompt(q, k, v, slopes, dil, steps):
    B, S, H, Dh = q.shape
    L = S // dil
    blk = steps
    nb = -(-L // blk)
    Lp = nb * blk

    def split_res(a):
        a = a.reshape(B, L, dil, H, Dh)
        return jnp.pad(a, ((0, 0), (0, Lp - L), (0, 0), (0, 0), (0, 0)))

    front = ((0, 0), (blk, 0), (0, 0), (0, 0), (0, 0))
    qr = split_res(q).reshape(B, nb, blk, dil, H, Dh)
    kr = jnp.pad(split_res(k), front).reshape(B, nb + 1, blk, dil, H, Dh)
    vr = jnp.pad(split_res(v), front).reshape(B, nb + 1, blk, dil, H, Dh)
    kw = jnp.concatenate([kr[:, :-1], kr[:, 1:]], axis=2)
    vw = jnp.concatenate([vr[:, :-1], vr[:, 1:]], axis=2)
    s = jnp.einsum('bnqrhd,bnkrhd->bnrhqk', qr, kw) * (Dh ** -0.5)
    qq = jnp.arange(blk)[:, None]
    kk = jnp.arange(2 * blk)[None, :]
    j = qq + blk - kk
    u_key = jnp.arange(nb)[:, None, None] * blk - blk + kk[None]
    valid = (j >= 0) & (j <= steps) & (u_key >= 0)
    s = s - slopes[:, None, None] * (j * dil).astype(jnp.float32)
    s = jnp.where(valid[None, :, None, None], s, NEG)
    m = jnp.max(s, axis=-1)
    p = jnp.exp(s - m[..., None])
    l = jnp.sum(p, axis=-1)
    num = jnp.einsum('bnrhqk,bnkrhd->bnqrhd', p, vw)
    m = m.transpose(0, 1, 4, 2, 3).reshape(B, Lp * dil, H)[:, :S]
    l = l.transpose(0, 1, 4, 2, 3).reshape(B, Lp * dil, H)[:, :S]
    num = num.reshape(B, Lp * dil, H, Dh)[:, :S]
    return m, l, num


def dilated_branch_sample(q, kc, vc, slopes, dil, steps, n_past):
    T = q.shape[1]
    j = jnp.arange(steps + 1)
    idx = n_past + jnp.arange(T)[:, None] - j[None, :] * dil
    valid = idx >= 0
    idxc = jnp.maximum(idx, 0)
    kg = jnp.take(kc, idxc, axis=1)
    vg = jnp.take(vc, idxc, axis=1)
    s = jnp.einsum('bthd,btjhd->bhtj', q, kg) * (q.shape[-1] ** -0.5)
    s = s - slopes[:, None, None] * (j * dil).astype(jnp.float32)[None, None, :]
    s = jnp.where(valid[None, None], s, NEG)
    m = jnp.max(s, axis=-1)
    p = jnp.exp(s - m[..., None])
    l = jnp.sum(p, axis=-1)
    num = jnp.einsum('bhtj,btjhd->bthd', p, vg)
    return m.transpose(0, 2, 1), l.transpose(0, 2, 1), num


def combine_by_denominator(parts):
    m = jnp.stack([pt[0] for pt in parts])
    l = jnp.stack([pt[1] for pt in parts])
    num = jnp.stack([pt[2] for pt in parts])
    wgt = jnp.exp(m - jnp.max(m, axis=0, keepdims=True))
    den = jnp.sum(wgt * l, axis=0)
    return jnp.sum(wgt[..., None] * num, axis=0) / den[..., None]


def token_mix(h, conv_buf, s0, win_k, win_v, w_in, w_conv, a_log, dt_bias, norm_out_a, norm_out_b, w_out):
    B, T, _ = h.shape
    f32 = jnp.float32
    proj = h @ w_in
    qkv_a, z_a, b_a, a_a, qkv_b = jnp.split(proj, SPLITS, axis=-1)
    conv_out, new_conv = causal_conv(qkv_a, conv_buf, w_conv)
    qa, ka, va = jnp.split(conv_out.astype(f32), [A_HEADS * A_DK, 2 * A_HEADS * A_DK], axis=-1)
    qa = l2norm(qa.reshape(B, T, A_HEADS, A_DK)) * (A_DK ** -0.5)
    ka = l2norm(ka.reshape(B, T, A_HEADS, A_DK))
    va = va.reshape(B, T, A_HEADS, A_DV)
    beta = jax.nn.sigmoid(b_a.astype(f32))
    g = -jnp.exp(a_log.astype(f32)) * jax.nn.softplus(a_a.astype(f32) + dt_bias.astype(f32))
    o_a, s_new = gated_delta_rule(qa, ka, va, g, beta, s0.astype(f32))
    o_a = rmsnorm(o_a, norm_out_a) * jax.nn.silu(z_a.astype(f32).reshape(B, T, A_HEADS, A_DV))
    qb, kb, vb = [t.reshape(B, T, B_HEADS, B_HEAD_DIM) for t in jnp.split(qkv_b, 3, axis=-1)]
    slopes = alibi_slopes()
    qf = qb.astype(f32)
    if win_k is None:
        kf, vf = kb.astype(f32), vb.astype(f32)
        parts = [dilated_branch_prompt(qf, kf, vf, slopes, d, w // d) for (w, d) in DILATED]
        keep = min(MAX_WINDOW, T)
        new_k, new_v = kb[:, T - keep:], vb[:, T - keep:]
    else:
        n_past = win_k.shape[1]
        kc = jnp.concatenate([win_k.astype(kb.dtype), kb], axis=1)
        vc = jnp.concatenate([win_v.astype(vb.dtype), vb], axis=1)
        kcf, vcf = kc.astype(f32), vc.astype(f32)
        parts = [dilated_branch_sample(qf, kcf, vcf, slopes, d, w // d, n_past) for (w, d) in DILATED]
        keep = min(MAX_WINDOW, n_past + T)
        new_k, new_v = kc[:, n_past + T - keep:], vc[:, n_past + T - keep:]
    o_b = rmsnorm(combine_by_denominator(parts), norm_out_b)
    mixed = jnp.concatenate([o_a.reshape(B, T, A_WIDTH), o_b.reshape(B, T, B_WIDTH)], axis=-1).astype(h.dtype)
    return mixed @ w_out, new_conv, s_new.astype(h.dtype), new_k, new_v


def hybrid_block(x, conv_buf, s0, win_k, win_v, norm_mix, w_in, w_conv, a_log, dt_bias,
                 norm_out_a, norm_out_b, w_out, norm_ffn, w_gate, w_up, w_down):
    mix, new_conv, new_rec, new_k, new_v = token_mix(rmsnorm(x, norm_mix), conv_buf, s0, win_k, win_v,
                                                     w_in, w_conv, a_log, dt_bias, norm_out_a, norm_out_b, w_out)
    x = x + mix
    hf = rmsnorm(x, norm_ffn)
    x = x + (jax.nn.silu(hf @ w_gate) * (hf @ w_up)) @ w_down
    return x, new_conv, new_rec, new_k, new_v


def setup_inputs(seed: int = 0) -> dict:
    key = jax.random.key(seed)
    ks = jax.random.split(key, 20)
    f32 = jnp.float32
    win_buf = min(MAX_WINDOW, PAST_LEN)

    def nrm(k, shape, scale):
        return jax.random.normal(k, shape, f32) * scale

    dt = jnp.exp(jax.random.uniform(ks[10], (DEPTH, A_HEADS), f32, minval=math.log(1e-3), maxval=math.log(1e-1)))
    return {
        "x_prompt": nrm(ks[0], (BATCH, SEQ, D_MODEL), 1.0),
        "x_sample": nrm(ks[1], (DEC_BATCH, DEC_SEQ, D_MODEL), 1.0),
        "state_conv": nrm(ks[2], (DEPTH, DEC_BATCH, CONV_W - 1, CONV_DIM), 1.0),
        "state_rec": nrm(ks[3], (DEPTH, DEC_BATCH, A_HEADS, A_DK, A_DV), 0.5),
        "cache_win_k": nrm(ks[4], (DEPTH, DEC_BATCH, win_buf, B_HEADS, B_HEAD_DIM), 1.0),
        "cache_win_v": nrm(ks[5], (DEPTH, DEC_BATCH, win_buf, B_HEADS, B_HEAD_DIM), 1.0),
        "norm_mix": 1.0 + nrm(ks[6], (DEPTH, D_MODEL), 0.02),
        "w_in": nrm(ks[7], (DEPTH, D_MODEL, IN_COLS), D_MODEL ** -0.5),
        "w_conv": nrm(ks[8], (DEPTH, CONV_W, CONV_DIM), CONV_W ** -0.5),
        "a_log": jnp.log(jax.random.uniform(ks[9], (DEPTH, A_HEADS), f32, minval=1.0, maxval=16.0)),
        "dt_bias": dt + jnp.log(-jnp.expm1(-dt)),
        "norm_out_a": 1.0 + nrm(ks[11], (DEPTH, A_DV), 0.02),
        "norm_out_b": 1.0 + nrm(ks[12], (DEPTH, B_HEAD_DIM), 0.02),
        "w_out": nrm(ks[13], (DEPTH, MIX_WIDTH, D_MODEL), MIX_WIDTH ** -0.5),
        "norm_ffn": 1.0 + nrm(ks[14], (DEPTH, D_MODEL), 0.02),
        "w_gate": nrm(ks[15], (DEPTH, D_MODEL, D_FF), D_MODEL ** -0.5),
        "w_up": nrm(ks[16], (DEPTH, D_MODEL, D_FF), D_MODEL ** -0.5),
        "w_down": nrm(ks[17], (DEPTH, D_FF, D_MODEL), D_FF ** -0.5),
        "norm_final": 1.0 + nrm(ks[18], (D_MODEL,), 0.02),
    }


def reference(x_prompt, x_sample, state_conv, state_rec, cache_win_k, cache_win_v, norm_mix, w_in, w_conv,
              a_log, dt_bias, norm_out_a, norm_out_b, w_out, norm_ffn, w_gate, w_up, w_down, norm_final):
    xp, xs = x_prompt, x_sample
    bp = xp.shape[0]
    pc, pr, pk, pv = [], [], [], []
    sc, sr, sk, sv = [], [], [], []
    for layer in range(DEPTH):
        weights = (norm_mix[layer], w_in[layer], w_conv[layer], a_log[layer], dt_bias[layer], norm_out_a[layer],
                   norm_out_b[layer], w_out[layer], norm_ffn[layer], w_gate[layer], w_up[layer], w_down[layer])
        zero_conv = jnp.zeros((bp, CONV_W - 1, CONV_DIM), xp.dtype)
        zero_rec = jnp.zeros((bp, A_HEADS, A_DK, A_DV), jnp.float32)
        xp, c, r, k, v = hybrid_block(xp, zero_conv, zero_rec, None, None, *weights)
        pc.append(c); pr.append(r); pk.append(k); pv.append(v)
        xs, c, r, k, v = hybrid_block(xs, state_conv[layer], state_rec[layer], cache_win_k[layer],
                                      cache_win_v[layer], *weights)
        sc.append(c); sr.append(r); sk.append(k); sv.append(v)
    y_prompt = rmsnorm(xp, norm_final)
    y_sample = rmsnorm(xs, norm_final)
    return (y_prompt, y_sample, jnp.stack(pc), jnp.stack(pr), jnp.stack(pk), jnp.stack(pv),
            jnp.stack(sc), jnp.stack(sr), jnp.stack(sk), jnp.stack(sv))
```

```cpp
#include <hip/hip_runtime.h>
#include <hip/hip_cooperative_groups.h>
#include <cstdio>
namespace cg = cooperative_groups;

#ifndef ONE_LAUNCH
#define ONE_LAUNCH 1
#endif

typedef unsigned short u16;
typedef __attribute__((ext_vector_type(8))) short bf16x8;
typedef __attribute__((ext_vector_type(4))) short bf16x4;
typedef __attribute__((ext_vector_type(4))) float f32x4;
typedef __attribute__((ext_vector_type(2))) float f32x2;

constexpr int DM = 1024, NPR = 16384, NSM = 256, NT = 16640, SEQ = 4096;
constexpr int CONVD = 1536, INC = 3592, NPROJ = 3584, DFF = 2816, NGU = 5632;
constexpr float EPS = 1e-6f;
constexpr size_t O_Y = 0;
constexpr size_t O_CONVP = (size_t)NT * DM;
constexpr size_t O_RECP = O_CONVP + 4 * 3 * 1536;
constexpr size_t O_WKP = O_RECP + 4 * 4 * 128 * 128;
constexpr size_t O_WVP = O_WKP + (size_t)4 * 2048 * 512;
constexpr size_t O_CONVS = O_WVP + (size_t)4 * 2048 * 512;
constexpr size_t O_RECS = O_CONVS + 32 * 3 * 1536;
constexpr size_t O_WKS = O_RECS + (size_t)32 * 4 * 128 * 128;
constexpr size_t O_WVS = O_WKS + (size_t)32 * 2048 * 512;
constexpr size_t O_END = O_WVS + (size_t)32 * 2048 * 512;
constexpr size_t WS_CTL = 0;
constexpr size_t WS_BAR = 8192;
constexpr size_t WS_WIN = 32768;
constexpr int NPROJP = 3840;
constexpr size_t WS_WOUT = WS_WIN + (size_t)NPROJP * DM * 2;
constexpr size_t WS_WGU = WS_WOUT + (size_t)DM * DM * 2;
constexpr size_t WS_WD = WS_WGU + (size_t)NGU * DM * 2;
constexpr size_t WS_H = WS_WD + (size_t)DM * DFF * 2;
constexpr size_t WS_QKVA = WS_H + (size_t)NT * DM * 2;
constexpr size_t WS_Z = WS_QKVA + (size_t)NT * CONVD * 2;
constexpr size_t WS_QB = WS_Z + (size_t)NT * 512 * 2;
constexpr size_t WS_KB = WS_QB + (size_t)NT * 512 * 2;
constexpr size_t WS_VB = WS_KB + (size_t)NT * 512 * 2;
constexpr size_t WS_BETA = WS_VB + (size_t)NT * 512 * 2;
constexpr size_t WS_G = WS_BETA + (size_t)NT * 4 * 4;
constexpr size_t GREC = 73728;
constexpr int NREC = 1152;
constexpr size_t WS_GDN = WS_G + (size_t)NT * 4 * 4;
constexpr size_t WS_EGL = WS_GDN + (size_t)NREC * GREC;
constexpr size_t WS_MIX = WS_EGL + 8192;
constexpr size_t WS_X1 = WS_MIX + (size_t)NT * DM * 2;
constexpr size_t WS_ACT = WS_X1 + (size_t)NT * DM * 4;
constexpr size_t WS_PART4 = WS_ACT + (size_t)NT * DFF * 2;
constexpr size_t WS_PART7 = WS_PART4 + (size_t)4 * 256 * 1024 * 4;
constexpr size_t WS_END = WS_PART7 + (size_t)11 * 256 * 1024 * 4;

constexpr int LDS_BYTES = 163840;
constexpr int NTHR = 512;

struct Args { const float* in[19]; float* out; unsigned char* ws; int ph_lo, ph_hi; };

__device__ __forceinline__ int fresh_tid() { int t = threadIdx.x; asm volatile("" : "+v"(t)); return t; }
typedef __attribute__((ext_vector_type(2))) __bf16 hbf2;
typedef __attribute__((ext_vector_type(4))) unsigned u32x4;
__device__ __forceinline__ unsigned pack2(float a, float b) {
  f32x2 v; v[0] = a; v[1] = b;
  hbf2 r = __builtin_convertvector(v, hbf2);
  return __builtin_bit_cast(unsigned, r);
}
__device__ __forceinline__ u16 f2bf(float f) { return (u16)(pack2(f, 0.f) & 0xffffu); }
__device__ __forceinline__ float bf2f(u16 h) { return __uint_as_float(((unsigned)h) << 16); }
__device__ __forceinline__ float bflo(unsigned u) { return __uint_as_float(u << 16); }
__device__ __forceinline__ float bfhi(unsigned u) { return __uint_as_float(u & 0xffff0000u); }
__device__ __forceinline__ float silu_f(float x) { return x * __builtin_amdgcn_rcpf(1.f + __expf(-x)); }
__device__ __forceinline__ bf16x8 pack8(f32x4 a, f32x4 b) {
  u32x4 r; r[0] = pack2(a[0], a[1]); r[1] = pack2(a[2], a[3]); r[2] = pack2(b[0], b[1]); r[3] = pack2(b[2], b[3]);
  return __builtin_bit_cast(bf16x8, r);
}
__device__ __forceinline__ float wave_sum(float v) {
  v += __shfl_xor(v, 1); v += __shfl_xor(v, 2); v += __shfl_xor(v, 4);
  v += __shfl_xor(v, 8); v += __shfl_xor(v, 16); v += __shfl_xor(v, 32);
  return v;
}

constexpr int BM = 256, BK = 64, HALF = 128, HT = HALF * BK;
__device__ __forceinline__ int lds_byte(int r, int c) {
  int st = (r >> 4) * 2 + (c >> 5), rr = r & 15, cc = c & 31, ob = rr * 64 + cc * 2;
  return st * 1024 + (ob ^ (((ob >> 9) & 1) << 5));
}
__device__ __forceinline__ void stage_rc(int b, int& R, int& C) {
  int st = b / 1024, sb = b % 1024, swz = sb ^ (((sb >> 9) & 1) << 5);
  R = (st >> 1) * 16 + swz / 64; C = (st & 1) * 32 + (swz % 64) / 2;
}

template <class Epi>
__device__ __forceinline__ void gemm_tile(unsigned char* ldsraw, const u16* __restrict__ A, const u16* __restrict__ Bt,
                                          const int K, const int ldk, const int brow, const int bcol, Epi epi,
                                          const bool pre = false, const bool has_next = false, const int nbrow = 0, const int nbcol = 0) {
  u16* shm = (u16*)ldsraw;
  const int gtid = fresh_tid();
#define SA(b, h) (shm + ((b) * 2 + (h)) * HT)
#define SB(b, h) (shm + (4 + (b) * 2 + (h)) * HT)
#define STAGE(P, BASE, br, kt) do { const u16* _gp = (BASE) + (long)(br) * ldk + (long)(kt) * BK; \
    __builtin_amdgcn_global_load_lds((const unsigned*)(_gp + soff0), (__attribute__((address_space(3))) unsigned*)((char*)(P) + gtid * 16), 16, 0, 0); \
    __builtin_amdgcn_global_load_lds((const unsigned*)(_gp + soff1), (__attribute__((address_space(3))) unsigned*)((char*)(P) + gtid * 16 + 8192), 16, 0, 0); } while (0)
#define LDA(dst, b, h) for (int m = 0; m < 4; ++m) for (int k = 0; k < 2; ++k) \
    dst[m][k] = *reinterpret_cast<const bf16x8*>((char*)SA(b, h) + lds_byte(wr * 64 + m * 16 + fr, k * 32 + fq * 8))
#define LDB(dst, b, h) for (int n = 0; n < 2; ++n) for (int k = 0; k < 2; ++k) \
    dst[n][k] = *reinterpret_cast<const bf16x8*>((char*)SB(b, h) + lds_byte(wc * 32 + n * 16 + fr, k * 32 + fq * 8))
#define MMA(ai, bj, At_, Bt_) do { __builtin_amdgcn_s_setprio(1); \
    for (int m = 0; m < 4; ++m) for (int n = 0; n < 2; ++n) for (int k = 0; k < 2; ++k) \
      acc[ai][bj][m][n] = __builtin_amdgcn_mfma_f32_16x16x32_bf16(At_[m][k], Bt_[n][k], acc[ai][bj][m][n], 0, 0, 0); \
    __builtin_amdgcn_s_setprio(0); } while (0)
#define WAIT_V(n) asm volatile("s_waitcnt vmcnt(" #n ")" ::: "memory")
#define WAIT_L(n) asm volatile("s_waitcnt lgkmcnt(" #n ")" ::: "memory")
#define BAR __builtin_amdgcn_s_barrier()
#define SCHED __builtin_amdgcn_sched_barrier(0)
  const int wid = gtid >> 6, lane = gtid & 63, wr = wid >> 2, wc = wid & 3, fr = lane & 15, fq = lane >> 4;
  int soff0, soff1;
  { int r_, c_; stage_rc(gtid * 16, r_, c_); soff0 = r_ * ldk + c_; stage_rc(gtid * 16 + 8192, r_, c_); soff1 = r_ * ldk + c_; }
  f32x4 acc[2][2][4][2];
#pragma unroll
  for (int i0 = 0; i0 < 2; ++i0)
#pragma unroll
    for (int i1 = 0; i1 < 2; ++i1)
#pragma unroll
      for (int i2 = 0; i2 < 4; ++i2)
#pragma unroll
        for (int i3 = 0; i3 < 2; ++i3) acc[i0][i1][i2][i3] = (f32x4){0.f, 0.f, 0.f, 0.f};
  bf16x8 At[4][2], B0[2][2], B1[2][2];
  const int nt = K / BK;
  if (!pre) {
    STAGE(SB(0, 0), Bt, bcol, 0); STAGE(SA(0, 0), A, brow, 0);
    STAGE(SB(0, 1), Bt, bcol + HALF, 0); STAGE(SA(0, 1), A, brow + HALF, 0);
  }
  if (wr == 1) BAR;
  WAIT_V(4); BAR;
  STAGE(SB(1, 0), Bt, bcol, 1); STAGE(SA(1, 0), A, brow, 1); STAGE(SB(1, 1), Bt, bcol + HALF, 1);
  WAIT_V(6); BAR;
  for (int t = 0; t < nt - 2; t += 2) {
    LDB(B0, 0, 0); SCHED; LDA(At, 0, 0); STAGE(SA(1, 1), A, brow + HALF, t + 1);
    WAIT_L(8); BAR; WAIT_L(0); MMA(0, 0, At, B0); BAR; SCHED;
    LDB(B1, 0, 1); STAGE(SB(0, 0), Bt, bcol, t + 2);
    BAR; WAIT_L(0); MMA(0, 1, At, B1); BAR;
    LDA(At, 0, 1); STAGE(SA(0, 0), A, brow, t + 2);
    BAR; WAIT_L(0); MMA(1, 0, At, B0); BAR; SCHED;
    STAGE(SB(0, 1), Bt, bcol + HALF, t + 2);
    WAIT_V(6); BAR; MMA(1, 1, At, B1); BAR;
    LDB(B0, 1, 0); SCHED; LDA(At, 1, 0); STAGE(SA(0, 1), A, brow + HALF, t + 2);
    WAIT_L(8); BAR; WAIT_L(0); MMA(0, 0, At, B0); BAR; SCHED;
    LDB(B1, 1, 1); STAGE(SB(1, 0), Bt, bcol, t + 3);
    BAR; WAIT_L(0); MMA(0, 1, At, B1); BAR;
    LDA(At, 1, 1); STAGE(SA(1, 0), A, brow, t + 3);
    BAR; WAIT_L(0); MMA(1, 0, At, B0); BAR; SCHED;
    STAGE(SB(1, 1), Bt, bcol + HALF, t + 3);
    WAIT_V(6); BAR; MMA(1, 1, At, B1); BAR;
  }
  { LDB(B0, 0, 0); LDA(At, 0, 0); STAGE(SA(1, 1), A, brow + HALF, nt - 1);
    BAR; WAIT_L(0); MMA(0, 0, At, B0); BAR;
    LDB(B1, 0, 1); BAR; WAIT_L(0); MMA(0, 1, At, B1); BAR;
    LDA(At, 0, 1); WAIT_V(4); BAR; WAIT_L(0); MMA(1, 0, At, B0); MMA(1, 1, At, B1); BAR; }
  { LDB(B0, 1, 0); LDA(At, 1, 0); WAIT_V(2); BAR; WAIT_L(0); MMA(0, 0, At, B0); BAR;
    LDB(B1, 1, 1); WAIT_V(0); BAR; WAIT_L(0); MMA(0, 1, At, B1); BAR;
    LDA(At, 1, 1); BAR; WAIT_L(0); MMA(1, 0, At, B0); MMA(1, 1, At, B1); BAR; }
  if (wr == 0) BAR;
  if (has_next) {
    STAGE(SB(0, 0), Bt, nbcol, 0); STAGE(SA(0, 0), A, nbrow, 0);
    STAGE(SB(0, 1), Bt, nbcol + HALF, 0); STAGE(SA(0, 1), A, nbrow + HALF, 0);
  }
#pragma unroll
  for (int ai = 0; ai < 2; ++ai)
#pragma unroll
    for (int bj = 0; bj < 2; ++bj)
#pragma unroll
      for (int m = 0; m < 4; ++m) {
        const int row0 = brow + ai * HALF + wr * 64 + m * 16 + fq * 4;
        const int col0 = bcol + bj * HALF + wc * 32 + fr;
        epi(acc[ai][bj][m][0], acc[ai][bj][m][1], row0, col0);
      }
  __syncthreads();
#undef SA
#undef SB
#undef STAGE
#undef LDA
#undef LDB
#undef MMA
}

constexpr int J_T0 = 480, J_T1 = J_T0 + 128, J_T2 = J_T1 + 704, J_T3 = J_T2 + 352;
constexpr int J_RMS = J_T3 + 1040;

__device__ __forceinline__ void p0_transpose(const Args& a, int job, unsigned char* lds) {
  float* tile = (float*)lds;
  const int tid = fresh_tid();
  int mat, nt_, kt_;
  if (job < J_T0) { mat = 0; nt_ = job / 16; kt_ = job % 16; }
  else if (job < J_T1) { mat = 1; int j = job - J_T0; nt_ = j / 16; kt_ = j % 16; }
  else if (job < J_T2) { mat = 2; int j = job - J_T1; nt_ = j / 16; kt_ = j % 16; }
  else { mat = 3; int j = job - J_T2; nt_ = j / 44; kt_ = j % 44; }
  const int n0 = nt_ * 128, k0 = kt_ * 64;
  const float* src; int ld, Kd; u16* dst;
  if (mat == 0) { src = a.in[7]; ld = INC; Kd = DM; dst = (u16*)(a.ws + WS_WIN); }
  else if (mat == 1) { src = a.in[13]; ld = DM; Kd = DM; dst = (u16*)(a.ws + WS_WOUT); }
  else if (mat == 2) { src = a.in[15]; ld = DFF; Kd = DM; dst = (u16*)(a.ws + WS_WGU); }
  else { src = a.in[17]; ld = DM; Kd = DFF; dst = (u16*)(a.ws + WS_WD); }
  float vals[16];
#pragma unroll
  for (int i = 0; i < 16; ++i) {
    int e = tid + 512 * i; int kl = e >> 7, nl = e & 127; int n = n0 + nl; int col; const float* s = src;
    bool zero_ = false;
    if (mat == 0) { if (n < 2048) col = n; else if (n < 3584) col = n + 8; else if (n < 3592) col = 2048 + (n - 3584); else { col = 0; zero_ = true; } }
    else if (mat == 2) { int t256 = n >> 8, bj = (n >> 7) & 1, wc = (n >> 5) & 3, nn = (n >> 4) & 1, fr = n & 15;
      col = t256 * 128 + bj * 64 + wc * 16 + fr; if (nn) s = a.in[16]; }
    else col = n;
    vals[i] = zero_ ? 0.f : s[(size_t)(k0 + kl) * ld + col];
  }
#pragma unroll
  for (int i = 0; i < 16; ++i) { int e = tid + 512 * i; tile[(e >> 7) * 129 + (e & 127)] = vals[i]; }
  __syncthreads();
  {
    int nl = tid >> 2, k16 = (tid & 3) * 16;
    bf16x8 v0, v1;
#pragma unroll
    for (int i = 0; i < 8; ++i) { v0[i] = (short)f2bf(tile[(k16 + i) * 129 + nl]); v1[i] = (short)f2bf(tile[(k16 + 8 + i) * 129 + nl]); }
    bf16x8* dp = reinterpret_cast<bf16x8*>(dst + (size_t)(n0 + nl) * Kd + k0 + k16);
    dp[0] = v0; dp[1] = v1;
  }
  __syncthreads();
}

template <int MODE>
__device__ __forceinline__ void rms_row_bf16(const Args& a, const float* __restrict__ xrow, const float* __restrict__ nw,
                                             u16* __restrict__ hrow, int row) {
  const int lane = fresh_tid() & 63;
  f32x4 x[4];
  float ss = 0.f;
#pragma unroll
  for (int i = 0; i < 4; ++i) {
    x[i] = *reinterpret_cast<const f32x4*>(xrow + (i * 64 + lane) * 4);
    ss += x[i][0] * x[i][0] + x[i][1] * x[i][1] + x[i][2] * x[i][2] + x[i][3] * x[i][3];
  }
  ss = wave_sum(ss);
  const float rstd = rsqrtf(ss * (1.f / 1024.f) + EPS);
  float dot[8];
  if (MODE == 0) {
#pragma unroll
    for (int c = 0; c < 8; ++c) dot[c] = 0.f;
  }
#pragma unroll
  for (int i = 0; i < 4; ++i) {
    f32x4 w = *reinterpret_cast<const f32x4*>(nw + (i * 64 + lane) * 4);
    f32x4 h;
    h[0] = x[i][0] * rstd * w[0]; h[1] = x[i][1] * rstd * w[1]; h[2] = x[i][2] * rstd * w[2]; h[3] = x[i][3] * rstd * w[3];
    uint2 pk; pk.x = pack2(h[0], h[1]); pk.y = pack2(h[2], h[3]);
    *reinterpret_cast<uint2*>(hrow + (i * 64 + lane) * 4) = pk;
    if (MODE == 0) {
      const float* wi = a.in[7];
#pragma unroll
      for (int e = 0; e < 4; ++e) {
        int k = (i * 64 + lane) * 4 + e;
        f32x4 w0 = *reinterpret_cast<const f32x4*>(wi + (size_t)k * INC + 2048);
        f32x4 w1 = *reinterpret_cast<const f32x4*>(wi + (size_t)k * INC + 2052);
        dot[0] += h[e] * w0[0]; dot[1] += h[e] * w0[1]; dot[2] += h[e] * w0[2]; dot[3] += h[e] * w0[3];
        dot[4] += h[e] * w1[0]; dot[5] += h[e] * w1[1]; dot[6] += h[e] * w1[2]; dot[7] += h[e] * w1[3];
      }
    }
  }
  if (MODE == 0) {
#pragma unroll
    for (int c = 0; c < 8; ++c) dot[c] = wave_sum(dot[c]);
    float* BETA = (float*)(a.ws + WS_BETA); float* G = (float*)(a.ws + WS_G);
    if (lane < 4) {
      float bv = (lane == 0) ? dot[0] : (lane == 1) ? dot[1] : (lane == 2) ? dot[2] : dot[3];
      float av = (lane == 0) ? dot[4] : (lane == 1) ? dot[5] : (lane == 2) ? dot[6] : dot[7];
      float beta = 1.f / (1.f + expf(-bv));
      float xx = av + a.in[10][lane];
      float sp = (xx > 20.f) ? xx : log1pf(expf(xx));
      float g = -expf(a.in[9][lane]) * sp;
      BETA[row * 4 + lane] = beta; G[row * 4 + lane] = g;
    }
  }
}

__device__ __forceinline__ void phase0(const Args& a, unsigned char* lds) {
  const int tid = fresh_tid(), wave = tid >> 6;
  const bool defer = (gridDim.x == 256);
  for (int job = blockIdx.x; job < J_RMS; job += gridDim.x) {
    if (defer && job >= J_T0 && job < J_T3) continue;
    if (job < J_T3) p0_transpose(a, job, lds);
    else {
#pragma unroll
      for (int rr = 0; rr < 2; ++rr) {
        int row = (job - J_T3) * 16 + wave * 2 + rr;
        const float* xr = (row < NPR) ? a.in[0] + (size_t)row * DM : a.in[1] + (size_t)(row - NPR) * DM;
        rms_row_bf16<1>(a, xr, a.in[6], (u16*)(a.ws + WS_H) + (size_t)row * DM, row);
      }
    }
  }
}
__device__ __forceinline__ void copy_range(const Args& a, int j0, int j1, int first, int stride, int tid);
__device__ __forceinline__ void copy_job(const Args& a, int jb, int tid) {
#pragma unroll
  for (int i = 0; i < 8; ++i) {
    int idx = jb * 4096 + i * 512 + tid;
    int ab = idx / 261120, off = idx - ab * 261120;
    int arr = ab >> 5, b = ab & 31;
    const float* src = (arr ? a.in[5] : a.in[4]) + (size_t)b * 1048576 + 4096 + (size_t)off * 4;
    float* dst = a.out + (arr ? O_WVS : O_WKS) + (size_t)b * 1048576 + (size_t)off * 4;
    f32x4 v = __builtin_nontemporal_load(reinterpret_cast<const f32x4*>(src));
    __builtin_nontemporal_store(v, reinterpret_cast<f32x4*>(dst));
  }
}

__device__ __forceinline__ void copy_range(const Args& a, int j0, int j1, int first, int stride, int tid) {
  int jb = j0 + first;
  for (; jb + stride < j1; jb += 2 * stride) {
    f32x4 v[16];
#pragma unroll
    for (int i = 0; i < 16; ++i) {
      int idx = ((i < 8) ? jb : jb + stride) * 4096 + (i & 7) * 512 + tid;
      int ab = idx / 261120, off = idx - ab * 261120; int arr = ab >> 5, b = ab & 31;
      const float* src = (arr ? a.in[5] : a.in[4]) + (size_t)b * 1048576 + 4096 + (size_t)off * 4;
      v[i] = __builtin_nontemporal_load(reinterpret_cast<const f32x4*>(src));
    }
#pragma unroll
    for (int i = 0; i < 16; ++i) {
      int idx = ((i < 8) ? jb : jb + stride) * 4096 + (i & 7) * 512 + tid;
      int ab = idx / 261120, off = idx - ab * 261120; int arr = ab >> 5, b = ab & 31;
      float* dst = a.out + (arr ? O_WVS : O_WKS) + (size_t)b * 1048576 + (size_t)off * 4;
      __builtin_nontemporal_store(v[i], reinterpret_cast<f32x4*>(dst));
    }
  }
  if (jb < j1) copy_job(a, jb, tid);
}
typedef unsigned long long u64;
__device__ __forceinline__ void st_wt16(void* p, bf16x8 v) {
  typedef __attribute__((ext_vector_type(2))) u64 u64x2;
  u64x2 q = __builtin_bit_cast(u64x2, v);
  __hip_atomic_store((u64*)p, q[0], __ATOMIC_RELAXED, __HIP_MEMORY_SCOPE_AGENT);
  __hip_atomic_store((u64*)p + 1, q[1], __ATOMIC_RELAXED, __HIP_MEMORY_SCOPE_AGENT);
}
__device__ __forceinline__ void st_wt8(void* p, bf16x4 v) {
  __hip_atomic_store((u64*)p, __builtin_bit_cast(u64, v), __ATOMIC_RELAXED, __HIP_MEMORY_SCOPE_AGENT);
}
template <class G>
__device__ __forceinline__ void emit_frag(bf16x8* __restrict__ dst, int nR, int nKs, G get) {
  const int total = nR * nKs * 64;
  for (int idx = fresh_tid(); idx < total; idx += NTHR) {
    int f = idx >> 6, l = idx & 63; int R = f / nKs, ks = f - R * nKs; int m = l & 15, kg = l >> 4;
    int row = 16 * R + m, c0 = 32 * ks + 4 * kg;
    bf16x8 v;
#pragma unroll
    for (int j = 0; j < 4; ++j) { v[j] = (short)f2bf(get(row, c0 + j)); v[4 + j] = (short)f2bf(get(row, c0 + 16 + j)); }
    st_wt16(dst + idx, v);
  }
}

__device__ __forceinline__ void gdn_prep_item(const Args& a, int item, unsigned char* lds) {
  float* Kf = (float*)lds;
  float* Qf = Kf + 64 * 132;
  float* Vb = Qf + 64 * 132;
  float* Lm = Vb + 64 * 132;
  float* QKm = Lm + 64 * 68;
  float* gc = QKm + 64 * 68;
  float* bet = gc + 64;
  float* gg = bet + 64;
  float* Ti = gg + 64;
  const int tid = fresh_tid(), lane = tid & 63, wave = tid >> 6;
  const bool samp = item >= 1024;
  int b, h, ch, row0, ntok;
  if (!samp) { int bh = item >> 6; ch = item & 63; b = bh >> 2; h = bh & 3; row0 = b * SEQ + ch * 64; ntok = 64; }
  else { int s = item - 1024; b = s >> 2; h = s & 3; ch = 0; row0 = NPR + b * 8; ntok = 8; }
  const u16* QKVA = (const u16*)(a.ws + WS_QKVA);
  const float* BETA = (const float*)(a.ws + WS_BETA);
  const float* Gg = (const float*)(a.ws + WS_G);
  unsigned char* rec = a.ws + WS_GDN + (size_t)item * GREC;
  {
    const int t0 = wave * 8;
    float betv[8];
#pragma unroll
    for (int i = 0; i < 8; ++i) {
      const int t = t0 + i; float be = 0.f, g = 0.f;
      if (t < ntok) { be = BETA[(row0 + t) * 4 + h]; g = Gg[(row0 + t) * 4 + h]; }
      betv[i] = be;
      if (lane == 0) { bet[t] = be; gg[t] = g; }
    }
#pragma unroll
    for (int seg = 0; seg < 3; ++seg) {
      const int cb = seg * 512 + h * 128 + 2 * lane;
      float* dstm = (seg == 0) ? Qf : (seg == 1) ? Kf : Vb;
      float w0[4], w1[4];
#pragma unroll
      for (int i = 0; i < 4; ++i) { f32x2 ww = *reinterpret_cast<const f32x2*>(a.in[8] + i * CONVD + cb); w0[i] = ww[0]; w1[i] = ww[1]; }
      float r0[11], r1[11];
#pragma unroll
      for (int i = 0; i < 11; ++i) {
        int tk = t0 - 3 + i;
        float v0 = 0.f, v1 = 0.f;
        if (!samp) {
          int pos = ch * 64 + tk;
          if (pos >= 0) { unsigned u = *reinterpret_cast<const unsigned*>(QKVA + (size_t)(b * SEQ + pos) * CONVD + cb); v0 = bflo(u); v1 = bfhi(u); }
        } else {
          if (tk < 0) { f32x2 sv = *reinterpret_cast<const f32x2*>(a.in[2] + (size_t)(b * 3 + 3 + tk) * CONVD + cb); v0 = sv[0]; v1 = sv[1]; }
          else if (tk < 8) { unsigned u = *reinterpret_cast<const unsigned*>(QKVA + (size_t)(NPR + b * 8 + tk) * CONVD + cb); v0 = bflo(u); v1 = bfhi(u); }
        }
        r0[i] = v0; r1[i] = v1;
      }
#pragma unroll
      for (int i = 0; i < 8; ++i) {
        const int t = t0 + i;
        float c0 = silu_f(r0[i] * w0[0] + r0[i + 1] * w0[1] + r0[i + 2] * w0[2] + r0[i + 3] * w0[3]);
        float c1 = silu_f(r1[i] * w1[0] + r1[i + 1] * w1[1] + r1[i + 2] * w1[2] + r1[i + 3] * w1[3]);
        float sc = (t < ntok) ? ((seg == 2) ? betv[i] : 1.f) : 0.f;
        f32x2 o2; o2[0] = c0 * sc; o2[1] = c1 * sc;
        *reinterpret_cast<f32x2*>(dstm + t * 132 + 2 * lane) = o2;
      }
    }
  }
  __syncthreads();
  {
    const int tok = tid >> 3, part = tid & 7;
    float* qp = Qf + tok * 132 + 16 * part; float* kp = Kf + tok * 132 + 16 * part;
    f32x4 qv[4], kv[4]; float sq = 0.f, sk = 0.f;
#pragma unroll
    for (int i = 0; i < 4; ++i) {
      qv[i] = *reinterpret_cast<const f32x4*>(qp + 4 * i); kv[i] = *reinterpret_cast<const f32x4*>(kp + 4 * i);
      sq += qv[i][0] * qv[i][0] + qv[i][1] * qv[i][1] + qv[i][2] * qv[i][2] + qv[i][3] * qv[i][3];
      sk += kv[i][0] * kv[i][0] + kv[i][1] * kv[i][1] + kv[i][2] * kv[i][2] + kv[i][3] * kv[i][3];
    }
    sq += __shfl_xor(sq, 1); sq += __shfl_xor(sq, 2); sq += __shfl_xor(sq, 4);
    sk += __shfl_xor(sk, 1); sk += __shfl_xor(sk, 2); sk += __shfl_xor(sk, 4);
    const float rq = rsqrtf(sq + EPS) * 0.08838834764831845f, rk = rsqrtf(sk + EPS);
#pragma unroll
    for (int i = 0; i < 4; ++i) {
      *reinterpret_cast<f32x4*>(qp + 4 * i) = qv[i] * rq;
      *reinterpret_cast<f32x4*>(kp + 4 * i) = kv[i] * rk;
    }
    if (wave == 0) {
      float x = gg[lane];
#pragma unroll
      for (int off = 1; off < 64; off <<= 1) { float y = __shfl_up(x, off); if (lane >= off) x += y; }
      gc[lane] = x;
    }
  }
  __syncthreads();
  {
    const int m = lane & 15, kq = lane >> 4;
    const int ct = wave >> 1;
#pragma unroll
    for (int ss = 0; ss < 2; ++ss) {
      const int st = (wave & 1) * 2 + ss;
      f32x4 akk = (f32x4){0.f, 0.f, 0.f, 0.f}, aqk = (f32x4){0.f, 0.f, 0.f, 0.f};
      if (st <= ct) {
        const float* kap = Kf + (16 * ct + m) * 132 + 4 * kq;
        const float* qap = Qf + (16 * ct + m) * 132 + 4 * kq;
        const float* kbp = Kf + (16 * st + m) * 132 + 4 * kq;
#pragma unroll
        for (int blk = 0; blk < 8; ++blk) {
          f32x4 ka = *reinterpret_cast<const f32x4*>(kap + 16 * blk);
          f32x4 qa = *reinterpret_cast<const f32x4*>(qap + 16 * blk);
          f32x4 kb = *reinterpret_cast<const f32x4*>(kbp + 16 * blk);
#pragma unroll
          for (int t = 0; t < 4; ++t) {
            akk = __builtin_amdgcn_mfma_f32_16x16x4f32(ka[t], kb[t], akk, 0, 0, 0);
            aqk = __builtin_amdgcn_mfma_f32_16x16x4f32(qa[t], kb[t], aqk, 0, 0, 0);
          }
        }
      }
      const int s = 16 * st + m;
      const float gcs = gc[s];
#pragma unroll
      for (int j = 0; j < 4; ++j) {
        const int c = 16 * ct + 4 * kq + j;
        float arg = (s <= c) ? (gc[c] - gcs) : 0.f;
        float dec = __expf(arg);
        Lm[c * 68 + s] = (s < c) ? bet[c] * akk[j] * dec : 0.f;
        QKm[c * 68 + s] = (s <= c) ? aqk[j] * dec : 0.f;
      }
    }
  }
  __syncthreads();
  {
    const float gl = gc[63];
    emit_frag((bf16x8*)(rec + 16384), 4, 4, [&](int row, int col) { return Qf[row * 132 + col] * __expf(gc[row]); });
    emit_frag((bf16x8*)(rec + 32768), 8, 2, [&](int row, int col) { return Kf[col * 132 + row] * __expf(gl - gc[col]); });
    emit_frag((bf16x8*)(rec + 49152), 4, 2, [&](int row, int col) { return QKm[row * 68 + col]; });
    if (tid >= 64 && tid < 128) { f32x4 e4 = (f32x4){__expf(gl), __expf(gl), __expf(gl), __expf(gl)}; st_wt16(rec + 49152 + 1024 + (tid - 64) * 16, __builtin_bit_cast(bf16x8, e4)); }
  }
  __syncthreads();
  if (wave == 0) {
    const int blk = lane >> 4, jc = lane & 15;
    float x[16];
#pragma unroll
    for (int r = 0; r < 16; ++r) x[r] = 0.f;
#pragma unroll
    for (int r = 0; r < 16; ++r) {
      float acc = (r == jc) ? 1.f : 0.f;
#pragma unroll
      for (int q = 0; q < (r + 3) / 4; ++q) {
        f32x4 l4 = *reinterpret_cast<const f32x4*>(Lm + (16 * blk + r) * 68 + 16 * blk + 4 * q);
        acc -= l4[0] * x[4 * q] + l4[1] * x[4 * q + 1] + l4[2] * x[4 * q + 2] + l4[3] * x[4 * q + 3];
      }
      x[r] = acc;
    }
#pragma unroll
    for (int r = 0; r < 16; ++r) Ti[blk * 320 + r * 20 + jc] = x[r];
  } else {
    for (int idx = tid - 64; idx < 64 * 128; idx += 448) {
      const int c = idx >> 7, col = idx & 127;
      Qf[c * 132 + col] = Kf[c * 132 + col] * bet[c] * __expf(gc[c]);
    }
  }
  __syncthreads();
  {
    const int m = lane & 15, kq = lane >> 4;
    float* R = (wave < 4) ? Vb : Qf;
    const int cbase = 32 * (wave & 3);
    f32x4 X[4][2];
#pragma unroll
    for (int i = 0; i < 4; ++i) {
      f32x4 Y[2];
#pragma unroll
      for (int nt = 0; nt < 2; ++nt)
#pragma unroll
        for (int j = 0; j < 4; ++j) Y[nt][j] = R[(16 * i + 4 * kq + j) * 132 + cbase + 16 * nt + m];
#pragma unroll
      for (int p = 0; p < i; ++p) {
        f32x4 l4 = *reinterpret_cast<const f32x4*>(Lm + (16 * i + m) * 68 + 16 * p + 4 * kq);
#pragma unroll
        for (int t = 0; t < 4; ++t)
#pragma unroll
          for (int nt = 0; nt < 2; ++nt) Y[nt] = __builtin_amdgcn_mfma_f32_16x16x4f32(-l4[t], X[p][nt][t], Y[nt], 0, 0, 0);
      }
      f32x4 t4 = *reinterpret_cast<const f32x4*>(Ti + i * 320 + m * 20 + 4 * kq);
#pragma unroll
      for (int nt = 0; nt < 2; ++nt) {
        f32x4 zacc = (f32x4){0.f, 0.f, 0.f, 0.f};
#pragma unroll
        for (int t = 0; t < 4; ++t) zacc = __builtin_amdgcn_mfma_f32_16x16x4f32(t4[t], Y[nt][t], zacc, 0, 0, 0);
        X[i][nt] = zacc;
      }
    }
    if (wave < 4) {
      bf16x4* UF = (bf16x4*)(rec + 57344);
#pragma unroll
      for (int i = 0; i < 4; ++i)
#pragma unroll
        for (int nt = 0; nt < 2; ++nt) {
          bf16x4 u4; u4[0] = (short)f2bf(X[i][nt][0]); u4[1] = (short)f2bf(X[i][nt][1]); u4[2] = (short)f2bf(X[i][nt][2]); u4[3] = (short)f2bf(X[i][nt][3]);
          st_wt8(UF + ((2 * wave + nt) * 4 + i) * 64 + lane, u4);
        }
    } else {
#pragma unroll
      for (int i = 0; i < 4; ++i)
#pragma unroll
        for (int nt = 0; nt < 2; ++nt)
#pragma unroll
          for (int j = 0; j < 4; ++j) Qf[(16 * i + 4 * kq + j) * 132 + cbase + 16 * nt + m] = X[i][nt][j];
    }
  }
  __syncthreads();
  emit_frag((bf16x8*)(rec), 4, 4, [&](int row, int col) { return -Qf[row * 132 + col]; });
  asm volatile("s_waitcnt vmcnt(0)" ::: "memory");
  __syncthreads();
  if (tid == 0) __hip_atomic_store((int*)(a.ws + WS_CTL) + item, 1, __ATOMIC_RELAXED, __HIP_MEMORY_SCOPE_AGENT);
}

#define AS3 __attribute__((address_space(3)))
constexpr int SCAN_BUF = 57344;
__device__ __forceinline__ void scan_wait(const int* flags, int c, int nch, int& known) {
  if (known > c) return;
  const int lane = threadIdx.x & 63;
  while (known <= c) {
    const int idx = known + lane;
    int f = 0;
    if (lane < 16) f = (idx < nch) ? __hip_atomic_load(flags + idx, __ATOMIC_RELAXED, __HIP_MEMORY_SCOPE_AGENT) : 1;
    const unsigned long long m = __ballot(f != 0);
    const int cnt = __builtin_ctzll(~m);
    if (cnt == 0) __builtin_amdgcn_s_sleep(8);
    known += (cnt > 16) ? 16 : cnt;
  }
  __builtin_amdgcn_fence(__ATOMIC_ACQUIRE, "agent");
}
__device__ __forceinline__ void scan_dma(const unsigned char* rec, unsigned char* fbuf, unsigned char* ubuf, int t256) {
#pragma unroll
  for (int i = 0; i < 14; ++i)
    __builtin_amdgcn_global_load_lds((const unsigned*)(rec + (i * 256 + t256) * 16), (AS3 unsigned*)(fbuf + (i * 256 + t256) * 16), 16, 0, 0);
#pragma unroll
  for (int i = 0; i < 4; ++i)
    __builtin_amdgcn_global_load_lds((const unsigned*)(rec + 57344 + (i * 256 + t256) * 16), (AS3 unsigned*)(ubuf + (i * 256 + t256) * 16), 16, 0, 0);
}
__device__ __forceinline__ void gdn_scan_item(const Args& a, int sitem, unsigned char* lds) {
  unsigned char* Ub = lds + 2 * SCAN_BUF;
  u16* Ot = (u16*)(lds + 2 * SCAN_BUF + 32768);
  const int tid = fresh_tid(), lane = tid & 63, w = tid >> 6, n = lane & 15, rg = lane >> 4;
  const bool mw = w < 4;
  const bool samp = sitem >= 16;
  int bb, h, nch, rec0, rowbase; size_t orec;
  if (!samp) { bb = sitem >> 2; h = sitem & 3; nch = 64; rec0 = sitem * 64; rowbase = bb * SEQ; orec = O_RECP + (size_t)sitem * 16384; }
  else { int s = sitem - 16; bb = s >> 2; h = s & 3; nch = 1; rec0 = 1024 + s; rowbase = NPR + bb * 8; orec = O_RECS + (size_t)s * 16384; }
  const u16* Z = (const u16*)(a.ws + WS_Z);
  u16* MIX = (u16*)(a.ws + WS_MIX);
  const unsigned char* recb = a.ws + WS_GDN + (size_t)rec0 * GREC;
  __syncthreads();
  if (mw) {
    f32x4 S[8][2];
#pragma unroll
    for (int i = 0; i < 8; ++i) { S[i][0] = (f32x4){0.f, 0.f, 0.f, 0.f}; S[i][1] = (f32x4){0.f, 0.f, 0.f, 0.f}; }
    if (samp) {
      const float* sp = a.in[3] + (size_t)(sitem - 16) * 16384 + (4 * rg) * 128 + 32 * w + n;
#pragma unroll
      for (int i = 0; i < 8; ++i)
#pragma unroll
        for (int nt = 0; nt < 2; ++nt)
#pragma unroll
          for (int j = 0; j < 4; ++j) S[i][nt][j] = sp[(16 * i + j) * 128 + 16 * nt];
    }
    const int* flags = (const int*)(a.ws + WS_CTL) + rec0;
    int known = 0;
    scan_wait(flags, 0, nch, known);
    scan_dma(recb, lds, Ub, tid);
#pragma unroll 1
    for (int ch = 0; ch < nch; ++ch) {
      asm volatile("s_waitcnt vmcnt(0)" ::: "memory");
      __syncthreads();
      const unsigned char* bufp = lds + (ch & 1) * SCAN_BUF;
      const unsigned char* ubp = Ub + (ch & 1) * 16384;
      if (ch + 1 < nch) {
        scan_wait(flags, ch + 1, nch, known);
        scan_dma(recb + (size_t)(ch + 1) * GREC, lds + ((ch + 1) & 1) * SCAN_BUF, Ub + ((ch + 1) & 1) * 16384, tid);
      }
      const float egl = *(const float*)(bufp + 49152 + 1024);
      const bf16x8* WF = (const bf16x8*)bufp; const bf16x8* QGF = (const bf16x8*)(bufp + 16384);
      const bf16x8* KDF = (const bf16x8*)(bufp + 32768); const bf16x8* QKF = (const bf16x8*)(bufp + 49152);
      f32x4 e[4][2], o[4][2];
#pragma unroll
      for (int tt = 0; tt < 4; ++tt)
#pragma unroll
        for (int nt = 0; nt < 2; ++nt) {
          const uint2 u2 = ((const uint2*)ubp)[((2 * w + nt) * 4 + tt) * 64 + lane];
          e[tt][nt] = (f32x4){bflo(u2.x), bfhi(u2.x), bflo(u2.y), bfhi(u2.y)};
          o[tt][nt] = (f32x4){0.f, 0.f, 0.f, 0.f};
        }
#pragma unroll
      for (int ks = 0; ks < 4; ++ks) {
        const bf16x8 Sb0 = pack8(S[2 * ks][0], S[2 * ks + 1][0]);
        const bf16x8 Sb1 = pack8(S[2 * ks][1], S[2 * ks + 1][1]);
#pragma unroll
        for (int tt = 0; tt < 4; ++tt) {
          bf16x8 af = WF[(tt * 4 + ks) * 64 + lane];
          e[tt][0] = __builtin_amdgcn_mfma_f32_16x16x32_bf16(af, Sb0, e[tt][0], 0, 0, 0);
          e[tt][1] = __builtin_amdgcn_mfma_f32_16x16x32_bf16(af, Sb1, e[tt][1], 0, 0, 0);
        }
#pragma unroll
        for (int tc = 0; tc < 4; ++tc) {
          bf16x8 af = QGF[(tc * 4 + ks) * 64 + lane];
          o[tc][0] = __builtin_amdgcn_mfma_f32_16x16x32_bf16(af, Sb0, o[tc][0], 0, 0, 0);
          o[tc][1] = __builtin_amdgcn_mfma_f32_16x16x32_bf16(af, Sb1, o[tc][1], 0, 0, 0);
        }
      }
      bf16x8 eb[2][2];
#pragma unroll
      for (int kt = 0; kt < 2; ++kt)
#pragma unroll
        for (int nt = 0; nt < 2; ++nt) eb[kt][nt] = pack8(e[2 * kt][nt], e[2 * kt + 1][nt]);
#pragma unroll
      for (int tc = 0; tc < 4; ++tc) {
#pragma unroll
        for (int kt = 0; kt < 2; ++kt) {
          if (tc == 0 && kt == 1) continue;
          bf16x8 af = QKF[(tc * 2 + kt) * 64 + lane];
          o[tc][0] = __builtin_amdgcn_mfma_f32_16x16x32_bf16(af, eb[kt][0], o[tc][0], 0, 0, 0);
          o[tc][1] = __builtin_amdgcn_mfma_f32_16x16x32_bf16(af, eb[kt][1], o[tc][1], 0, 0, 0);
        }
      }
      __syncthreads();
#pragma unroll
      for (int tc = 0; tc < 4; ++tc)
#pragma unroll
        for (int nt = 0; nt < 2; ++nt)
#pragma unroll
          for (int j = 0; j < 4; ++j) { const int row = 16 * tc + 4 * rg + j; Ot[row * 128 + 16 * ((2 * w + nt) ^ (row & 7)) + n] = f2bf(o[tc][nt][j]); }
#pragma unroll
      for (int i = 0; i < 8; ++i) {
        f32x4 ac0 = S[i][0] * egl, ac1 = S[i][1] * egl;
#pragma unroll
        for (int kt = 0; kt < 2; ++kt) {
          bf16x8 af = KDF[(i * 2 + kt) * 64 + lane];
          ac0 = __builtin_amdgcn_mfma_f32_16x16x32_bf16(af, eb[kt][0], ac0, 0, 0, 0);
          ac1 = __builtin_amdgcn_mfma_f32_16x16x32_bf16(af, eb[kt][1], ac1, 0, 0, 0);
        }
        S[i][0] = ac0; S[i][1] = ac1;
      }
    }
    __syncthreads();
#pragma unroll
    for (int i = 0; i < 8; ++i)
#pragma unroll
      for (int nt = 0; nt < 2; ++nt)
#pragma unroll
        for (int j = 0; j < 4; ++j) a.out[orec + (16 * i + 4 * rg + j) * 128 + 32 * w + 16 * nt + n] = S[i][nt][j];
  } else {
    const int t = tid - 256, otok = t >> 2, oq = t & 3;
    const bool ovalid = samp ? (otok < 8) : true;
    float nw[32];
#pragma unroll
    for (int i = 0; i < 8; ++i) { f32x4 w4 = *reinterpret_cast<const f32x4*>(a.in[11] + 32 * oq + 4 * i); nw[4 * i] = w4[0]; nw[4 * i + 1] = w4[1]; nw[4 * i + 2] = w4[2]; nw[4 * i + 3] = w4[3]; }
    const size_t zoff = (size_t)(rowbase + (ovalid ? otok : 0)) * 512 + h * 128 + 32 * oq;
    uint4 zr[4];
    { const uint4* zp = reinterpret_cast<const uint4*>(Z + zoff);
#pragma unroll
      for (int i = 0; i < 4; ++i) zr[i] = zp[i]; }
#pragma unroll 1
    for (int ch = 0; ch <= nch; ++ch) {
      if (ch < nch) __syncthreads();
      uint4 ot[4];
      if (ch == nch) __syncthreads();
      if (ch > 0) {
#pragma unroll
        for (int gq = 0; gq < 2; ++gq) {
          const uint4* orp = reinterpret_cast<const uint4*>(Ot + otok * 128 + 16 * ((2 * oq + gq) ^ (otok & 7)));
          ot[2 * gq] = orp[0]; ot[2 * gq + 1] = orp[1];
        }
      }
      if (ch < nch) __syncthreads();
      if (ch > 0) {
        const int orow = rowbase + (ch - 1) * 64 + (ovalid ? otok : 0);
        const unsigned ov[16] = {ot[0].x, ot[0].y, ot[0].z, ot[0].w, ot[1].x, ot[1].y, ot[1].z, ot[1].w,
                                 ot[2].x, ot[2].y, ot[2].z, ot[2].w, ot[3].x, ot[3].y, ot[3].z, ot[3].w};
        const unsigned zz[16] = {zr[0].x, zr[0].y, zr[0].z, zr[0].w, zr[1].x, zr[1].y, zr[1].z, zr[1].w,
                                 zr[2].x, zr[2].y, zr[2].z, zr[2].w, zr[3].x, zr[3].y, zr[3].z, zr[3].w};
        if (ch < nch) {
          const uint4* zp = reinterpret_cast<const uint4*>(Z + zoff + (size_t)ch * 64 * 512);
#pragma unroll
          for (int i = 0; i < 4; ++i) zr[i] = zp[i];
        }
        float ss = 0.f;
#pragma unroll
        for (int q = 0; q < 16; ++q) { float x0 = bflo(ov[q]), x1 = bfhi(ov[q]); ss += x0 * x0 + x1 * x1; }
        ss += __shfl_xor(ss, 1); ss += __shfl_xor(ss, 2);
        const float rstd = rsqrtf(ss * (1.f / 128.f) + EPS);
        unsigned outp[16];
#pragma unroll
        for (int q = 0; q < 16; ++q) {
          float oa = bflo(ov[q]) * rstd * nw[2 * q] * silu_f(bflo(zz[q]));
          float ob = bfhi(ov[q]) * rstd * nw[2 * q + 1] * silu_f(bfhi(zz[q]));
          outp[q] = pack2(oa, ob);
        }
        if (ovalid) {
          uint4* op = reinterpret_cast<uint4*>(MIX + (size_t)orow * DM + h * 128 + 32 * oq);
#pragma unroll
          for (int i = 0; i < 4; ++i) op[i] = make_uint4(outp[4 * i], outp[4 * i + 1], outp[4 * i + 2], outp[4 * i + 3]);
        }
      }
    }
  }
  __syncthreads();
}

struct KVRegs { bf16x8 k[4], v[4]; };
__device__ __forceinline__ void attn_fetch(const Args& a, KVRegs& R, bool samp, int bb, int h, int krow0, int C0, int tid, int br) {
  const u16* KB = (const u16*)(a.ws + WS_KB);
  const u16* VB = (const u16*)(a.ws + WS_VB);
#pragma unroll
  for (int i = 0; i < 4; ++i) {
    const int idx = tid + 512 * i; const int tl = idx >> 3, seg = idx & 7; const int p = C0 + tl;
    bf16x8 kv = (bf16x8){0, 0, 0, 0, 0, 0, 0, 0}, vv = (bf16x8){0, 0, 0, 0, 0, 0, 0, 0};
    if (!samp) {
      kv = *reinterpret_cast<const bf16x8*>(KB + (size_t)(krow0 + p) * 512 + h * 64 + seg * 8);
      vv = *reinterpret_cast<const bf16x8*>(VB + (size_t)(krow0 + p) * 512 + h * 64 + seg * 8);
    } else if ((br == 0 && (tl & 15) >= 8) || (br == 2 && p < 1920)) {
    } else if (p < 2048) {
      const float* kp = a.in[4] + ((size_t)(bb * 2048 + p) * 8 + h) * 64 + seg * 8;
      const float* vp = a.in[5] + ((size_t)(bb * 2048 + p) * 8 + h) * 64 + seg * 8;
      f32x4 k0 = *reinterpret_cast<const f32x4*>(kp), k1 = *reinterpret_cast<const f32x4*>(kp + 4);
      f32x4 v0 = *reinterpret_cast<const f32x4*>(vp), v1 = *reinterpret_cast<const f32x4*>(vp + 4);
      kv = pack8(k0, k1); vv = pack8(v0, v1);
    } else if (p < 2056) {
      kv = *reinterpret_cast<const bf16x8*>(KB + (size_t)(NPR + bb * 8 + p - 2048) * 512 + h * 64 + seg * 8);
      vv = *reinterpret_cast<const bf16x8*>(VB + (size_t)(NPR + bb * 8 + p - 2048) * 512 + h * 64 + seg * 8);
    }
    R.k[i] = kv; R.v[i] = vv;
  }
}

__device__ __forceinline__ void attn_item(const Args& a, int item, unsigned char* lds) {
  float* St = (float*)lds;
  u16* Kc = (u16*)(lds + 69632);
  u16* Vr = (u16*)(lds + 69632 + 36864);
  const int tid = fresh_tid(), lane = tid & 63, w = tid >> 6, n = lane & 15, rg = lane >> 4;
  const bool samp = item >= 512;
  int bb, h, T0, nvalid, qrow0, krow0;
  if (!samp) { bb = item >> 7; h = (item >> 4) & 7; int sp = item & 15; T0 = sp * 256; nvalid = 256; qrow0 = bb * SEQ + T0; krow0 = bb * SEQ; }
  else { int s = item - 512; bb = s >> 3; h = s & 7; T0 = 2048; nvalid = 8; qrow0 = NPR + bb * 8; krow0 = 0; }
  const float slope = exp2f(-(float)(h + 1));
  const u16* QB = (const u16*)(a.ws + WS_QB);
  __syncthreads();
  for (int idx = tid; idx < 256 * 68; idx += NTHR) { int c = idx % 68; St[idx] = (c == 64) ? -1e30f : 0.f; }
  __syncthreads();
#pragma unroll 1
  for (int br = 0; br < 3; ++br) {
    const int d = (br == 0) ? 16 : (br == 1) ? 4 : 1;
    const int nq = 16 / d;
    const int nch = (br == 0) ? 9 : (br == 1) ? 3 : 2;
    const int nk = 256 / d;
    const int dsh = (br == 0) ? 4 : (br == 1) ? 2 : 0;
    int ur[2], uqt[2], utq[2]; bool uact[2];
    bf16x8 Qf[2][2]; f32x4 acc[2][4]; float mrun[2], lrun[2];
#pragma unroll
    for (int uu = 0; uu < 2; ++uu) {
      const int ui = 2 * w + uu;
      ur[uu] = ui / nq; uqt[uu] = ui % nq;
      utq[uu] = d * (16 * uqt[uu] + n) + ur[uu];
      uact[uu] = (d * 16 * uqt[uu] + ur[uu]) < nvalid;
      const bool qv = utq[uu] < nvalid;
#pragma unroll
      for (int s2 = 0; s2 < 2; ++s2) {
        bf16x8 q = (bf16x8){0, 0, 0, 0, 0, 0, 0, 0};
        if (qv) q = *reinterpret_cast<const bf16x8*>(QB + (size_t)(qrow0 + utq[uu]) * 512 + h * 64 + 32 * s2 + 8 * rg);
        Qf[uu][s2] = q;
      }
#pragma unroll
      for (int dt = 0; dt < 4; ++dt) acc[uu][dt] = *reinterpret_cast<const f32x4*>(St + utq[uu] * 68 + 16 * dt + 4 * rg);
      mrun[uu] = St[utq[uu] * 68 + 64];
      lrun[uu] = (rg == 0) ? St[utq[uu] * 68 + 65] : 0.f;
    }
    int ck = (nch - 1) - (T0 >> 8); if (ck < 0) ck = 0;
    KVRegs R;
    attn_fetch(a, R, samp, bb, h, krow0, T0 + 256 * (ck - (nch - 1)), tid, br);
#pragma unroll 1
    for (; ck < nch; ++ck) {
      __syncthreads();
#pragma unroll
      for (int i = 0; i < 4; ++i) {
        const int idx = tid + 512 * i; const int tl = idx >> 3, seg = idx & 7;
        const int kidx = (tl & (d - 1)) * nk + (tl >> dsh);
        *reinterpret_cast<bf16x8*>(Kc + kidx * 72 + seg * 8) = R.k[i];
        *reinterpret_cast<bf16x8*>(Vr + kidx * 72 + seg * 8) = R.v[i];
      }
      __syncthreads();
      if (ck + 1 < nch) attn_fetch(a, R, samp, bb, h, krow0, T0 + 256 * (ck + 1 - (nch - 1)), tid, br);
#pragma unroll
      for (int uu = 0; uu < 2; ++uu) {
        if (!uact[uu]) continue;
        const int r = ur[uu], qt = uqt[uu];
        for (int kt = 0; kt < nq; ++kt) {
          const int Dl = qt - kt - nq * (ck - (nch - 1));
          if (Dl < 0 || Dl > 8) continue;
          const int kbase = r * nk + 16 * kt;
          f32x4 s4 = (f32x4){0.f, 0.f, 0.f, 0.f};
#pragma unroll
          for (int s2 = 0; s2 < 2; ++s2) {
            bf16x8 ka = *reinterpret_cast<const bf16x8*>(Kc + (kbase + n) * 72 + 32 * s2 + 8 * rg);
            s4 = __builtin_amdgcn_mfma_f32_16x16x32_bf16(ka, Qf[uu][s2], s4, 0, 0, 0);
          }
          float sc[4]; bool vl[4]; float mloc = -1e30f;
#pragma unroll
          for (int jj = 0; jj < 4; ++jj) {
            const int j = 16 * Dl + n - (4 * rg + jj);
            vl[jj] = (j >= 0) && (j <= 128);
            sc[jj] = vl[jj] ? (s4[jj] * 0.125f - slope * (float)(j * d)) : -1e30f;
            mloc = fmaxf(mloc, sc[jj]);
          }
          mloc = fmaxf(mloc, __shfl_xor(mloc, 16));
          mloc = fmaxf(mloc, __shfl_xor(mloc, 32));
          const float mnew = fmaxf(mrun[uu], mloc);
          const float alpha = __expf(mrun[uu] - mnew);
          float p4[4]; float ps = 0.f;
#pragma unroll
          for (int jj = 0; jj < 4; ++jj) { p4[jj] = vl[jj] ? __expf(sc[jj] - mnew) : 0.f; ps += p4[jj]; }
          lrun[uu] = lrun[uu] * alpha + ps;
          mrun[uu] = mnew;
          bf16x4 pb;
          pb[0] = (short)f2bf(p4[0]); pb[1] = (short)f2bf(p4[1]); pb[2] = (short)f2bf(p4[2]); pb[3] = (short)f2bf(p4[3]);
#pragma unroll
          for (int dt = 0; dt < 4; ++dt) {
            bf16x4 va = __builtin_amdgcn_ds_read_tr16_b64_v4i16((AS3 bf16x4*)(Vr + (kbase + 4 * rg + (n >> 2)) * 72 + 16 * dt + 4 * (n & 3)));
            f32x4 t = acc[uu][dt] * alpha;
            acc[uu][dt] = __builtin_amdgcn_mfma_f32_16x16x16bf16_1k(va, pb, t, 0, 0, 0);
          }
        }
      }
    }
#pragma unroll
    for (int uu = 0; uu < 2; ++uu) {
      float lt = lrun[uu];
      lt += __shfl_xor(lt, 16); lt += __shfl_xor(lt, 32);
#pragma unroll
      for (int dt = 0; dt < 4; ++dt) *reinterpret_cast<f32x4*>(St + utq[uu] * 68 + 16 * dt + 4 * rg) = acc[uu][dt];
      if (rg == 0) { St[utq[uu] * 68 + 64] = mrun[uu]; St[utq[uu] * 68 + 65] = lt; }
    }
    __syncthreads();
  }
  {
    const int tq = tid >> 1, half = tid & 1;
    float v[32]; float ss = 0.f;
    const float linv = 1.f / St[tq * 68 + 65];
#pragma unroll
    for (int q = 0; q < 8; ++q) {
      f32x4 t4 = *reinterpret_cast<const f32x4*>(St + tq * 68 + 32 * half + 4 * q);
#pragma unroll
      for (int e = 0; e < 4; ++e) { float x = t4[e] * linv; v[4 * q + e] = x; ss += x * x; }
    }
    ss += __shfl_xor(ss, 1);
    const float rstd = rsqrtf(ss * (1.f / 64.f) + EPS);
    if (tq < nvalid) {
      u16* MIX = (u16*)(a.ws + WS_MIX);
      unsigned outp[16];
#pragma unroll
      for (int q = 0; q < 16; ++q) {
        float oa = v[2 * q] * rstd * a.in[12][32 * half + 2 * q];
        float ob = v[2 * q + 1] * rstd * a.in[12][32 * half + 2 * q + 1];
        outp[q] = pack2(oa, ob);
      }
      uint4* op = reinterpret_cast<uint4*>(MIX + (size_t)(qrow0 + tq) * DM + 512 + h * 64 + 32 * half);
#pragma unroll
      for (int q = 0; q < 4; ++q) op[q] = make_uint4(outp[4 * q], outp[4 * q + 1], outp[4 * q + 2], outp[4 * q + 3]);
    }
  }
  __syncthreads();
}

#define XB_TMO      128
#define XB_XCNT(j)  (256  + 64 * (j))
#define XB_XSUB(j)  (1280 + 64 * (j))
#define XB_XGEN(j)  (2304 + 64 * (j))
#define XB_TOP      3328
#define XB_TOPGEN   3392
#define XCD_BAR_WORDS 3456
#define XB_SPIN_CAP (1u << 20)
__device__ __forceinline__ unsigned xb_ld(unsigned* p)              { return __hip_atomic_load(p, __ATOMIC_RELAXED, __HIP_MEMORY_SCOPE_AGENT); }
__device__ __forceinline__ unsigned xb_add(unsigned* p, unsigned v) { return __hip_atomic_fetch_add(p, v, __ATOMIC_RELAXED, __HIP_MEMORY_SCOPE_AGENT); }
__device__ __forceinline__ unsigned xb_xcc_id() { return (unsigned)__builtin_amdgcn_s_getreg((3 << 11) | 20) & 0xFu; }
#define XB_SPIN(cond, bar) do { unsigned _sp = 0; while (cond) { __builtin_amdgcn_s_sleep(1); \
    if ((++_sp & 255u) == 0u) { if (xb_ld(&(bar)[XB_TMO])) break; if (_sp > XB_SPIN_CAP) { atomicAdd(&(bar)[XB_TMO], 1u); break; } } } } while (0)
struct XcdBarrier { unsigned* bar; unsigned x, nloc, nx; };
__device__ __forceinline__ void xcd_barrier_complete(unsigned* bar, unsigned x, unsigned& nloc, unsigned& nx) {
  const unsigned G = gridDim.x;
  unsigned sum, cnt, mine, sp = 0u;
  for (;;) {
    sum = 0u; cnt = 0u; mine = 0u;
#pragma unroll
    for (unsigned j = 0; j < 16; ++j) { const unsigned c = xb_ld(&bar[XB_XCNT(j)]); sum += c; cnt += (c > 0u) ? 1u : 0u; mine = (j == x) ? c : mine; }
    if (sum == G) break;
    __builtin_amdgcn_s_sleep(1);
    if ((++sp & 255u) == 0u) { if (xb_ld(&bar[XB_TMO])) break; if (sp > XB_SPIN_CAP) { atomicAdd(&bar[XB_TMO], 1u); break; } }
  }
  nloc = mine > 0u ? mine : 1u; nx = cnt > 0u ? cnt : 1u;
}
__device__ __forceinline__ void xcd_barrier(XcdBarrier& b) {
  asm volatile("s_waitcnt vmcnt(0)" ::: "memory");
  __syncthreads();
  if (threadIdx.x == 0) {
    unsigned* bar = b.bar;
    __builtin_amdgcn_s_waitcnt(0);
    unsigned nloc = b.nloc, nx = b.nx;
    if (nloc == 0u) { xcd_barrier_complete(bar, b.x, nloc, nx); }
    b.nloc = __builtin_amdgcn_readfirstlane(nloc); b.nx = __builtin_amdgcn_readfirstlane(nx);
    const unsigned old = xb_add(&bar[XB_XSUB(b.x)], 1u);
    const unsigned gen = old / nloc;
    if (old + 1u == (gen + 1u) * nloc) {
      __builtin_amdgcn_fence(__ATOMIC_RELEASE, "agent");
      asm volatile("s_waitcnt vmcnt(0)" ::: "memory");
      const unsigned og = xb_add(&bar[XB_TOP], 1u);
      const unsigned tg = og / nx;
      if (og + 1u == (tg + 1u) * nx) xb_add(&bar[XB_TOPGEN], 1u);
      else XB_SPIN(xb_ld(&bar[XB_TOPGEN]) == tg, bar);
      __builtin_amdgcn_fence(__ATOMIC_ACQUIRE, "agent");
      xb_add(&bar[XB_XGEN(b.x)], 1u);
      asm volatile("s_waitcnt vmcnt(0)" ::: "memory");
    } else {
      XB_SPIN(xb_ld(&bar[XB_XGEN(b.x)]) == gen, bar);
      __builtin_amdgcn_fence(__ATOMIC_ACQUIRE, "agent");
      asm volatile("s_waitcnt vmcnt(0)" ::: "memory");
    }
  }
  __syncthreads();
}

__device__ __forceinline__ bool tile_of(int round, int C, int& pm, int& pn, int& o) {
  const int b = blockIdx.x;
  o = (gridDim.x == 256) ? ((round * 8 + (b & 7)) * 32 + (b >> 3)) : (round * (int)gridDim.x + b);
  if (o >= 65 * C) return false;
  const int nfull = C >> 2;
  if (o < nfull * 260) { const int cg = o / 260, rem = o - cg * 260; pm = rem >> 2; pn = 4 * cg + (rem & 3); }
  else { const int rem = o - nfull * 260, w = C & 3; pm = rem / w; pn = 4 * nfull + (rem - pm * w); }
  return true;
}

__global__ void __launch_bounds__(NTHR) fwd_kernel(Args a) {
  extern __shared__ __attribute__((aligned(16))) unsigned char lds[];
  const int lo = a.ph_lo, hi = a.ph_hi;
  XcdBarrier xb; xb.bar = (unsigned*)(a.ws + WS_BAR); xb.x = xb_xcc_id(); xb.nloc = 0u; xb.nx = 0u;
  if (threadIdx.x == 0 && hi - lo > 1) (void)xb_add(&xb.bar[XB_XCNT(xb.x)], 1u);
  if (lo < 0) cg::this_grid().sync();
#ifndef PHM
#define PHM 0x1ff
#endif
#define IN(k) ((((PHM) >> (k)) & 1) && lo <= (k) && (k) < hi)
#ifndef REPM
#define REPM 0
#endif
#define NREP(k) ((((REPM) >> (k)) & 1) ? 2 : 1)
#define SEAM(k) do { if (IN(k) && IN((k) + 1)) { xcd_barrier(xb); } } while (0)
  if (IN(0)) for (int rep_ = 0; rep_ < NREP(0); ++rep_) { phase0(a, lds); }
  SEAM(0);
  if (IN(1)) for (int rep_ = 0; rep_ < NREP(1); ++rep_) {
    const u16* H = (const u16*)(a.ws + WS_H); const u16* W = (const u16*)(a.ws + WS_WIN);
    float* outp = a.out;
    int oslot = 0;
    for (int rnd = 0;; ++rnd) {
      int pm, pn; if (!tile_of(rnd, 15, pm, pn, oslot)) break;
      const int brow = pm * 256, bcol = pn * 256;
      if (pn < 6) {
        u16* dst = (u16*)(a.ws + WS_QKVA);
        gemm_tile(lds, H, W, DM, DM, brow, bcol, [=](f32x4 c0, f32x4 c1, int row0, int col0) {
          const unsigned o = (unsigned)row0 * 1536u + (unsigned)col0;
#pragma unroll
          for (int j = 0; j < 4; ++j) { dst[o + j * 1536] = f2bf(c0[j]); dst[o + j * 1536 + 16] = f2bf(c1[j]); }
          if (row0 < NPR) {
            if ((row0 & 4095) == 4092) {
              const unsigned oo = (unsigned)O_CONVP + (unsigned)((row0 >> 12) * 3) * 1536u + (unsigned)col0;
#pragma unroll
              for (int j = 1; j < 4; ++j) { outp[oo + (j - 1) * 1536] = c0[j]; outp[oo + (j - 1) * 1536 + 16] = c1[j]; }
            }
          } else if (((row0 - NPR) & 7) == 4) {
            const unsigned oo = (unsigned)O_CONVS + (unsigned)(((row0 - NPR) >> 3) * 3) * 1536u + (unsigned)col0;
#pragma unroll
            for (int j = 1; j < 4; ++j) { outp[oo + (j - 1) * 1536] = c0[j]; outp[oo + (j - 1) * 1536 + 16] = c1[j]; }
          }
        });
      } else if (pn < 10) {
        u16* dst = (u16*)(a.ws + (pn < 8 ? WS_Z : WS_QB));
        const int cbase = (pn < 8) ? 1536 : 2048;
        gemm_tile(lds, H, W, DM, DM, brow, bcol, [=](f32x4 c0, f32x4 c1, int row0, int col0) {
          const unsigned o = (unsigned)row0 * 512u + (unsigned)(col0 - cbase);
#pragma unroll
          for (int j = 0; j < 4; ++j) { dst[o + j * 512] = f2bf(c0[j]); dst[o + j * 512 + 16] = f2bf(c1[j]); }
        });
      } else if (pn < 14) {
        const bool isk = pn < 12;
        u16* dst = (u16*)(a.ws + (isk ? WS_KB : WS_VB));
        const int cbase = isk ? 2560 : 3072;
        const unsigned offp = (unsigned)(isk ? O_WKP : O_WVP), offs = (unsigned)(isk ? O_WKS : O_WVS);
        gemm_tile(lds, H, W, DM, DM, brow, bcol, [=](f32x4 c0, f32x4 c1, int row0, int col0) {
          const unsigned cl = (unsigned)(col0 - cbase);
          const unsigned o = (unsigned)row0 * 512u + cl;
#pragma unroll
          for (int j = 0; j < 4; ++j) { dst[o + j * 512] = f2bf(c0[j]); dst[o + j * 512 + 16] = f2bf(c1[j]); }
          if (row0 < NPR) {
            const int tt = row0 & 4095;
            if (tt >= 2048) {
              const unsigned oo = offp + ((unsigned)(row0 >> 12) * 2048u + (unsigned)(tt - 2048)) * 512u + cl;
#pragma unroll
              for (int j = 0; j < 4; ++j) { outp[oo + j * 512] = c0[j]; outp[oo + j * 512 + 16] = c1[j]; }
            }
          } else {
            const int r2 = row0 - NPR;
            const unsigned oo = offs + ((unsigned)(r2 >> 3) * 2048u + 2040u + (unsigned)(r2 & 7)) * 512u + cl;
#pragma unroll
            for (int j = 0; j < 4; ++j) { outp[oo + j * 512] = c0[j]; outp[oo + j * 512 + 16] = c1[j]; }
          }
        });
      } else {
        float* BETA = (float*)(a.ws + WS_BETA); float* Gd = (float*)(a.ws + WS_G);
        const float* alog = a.in[9]; const float* dtb = a.in[10];
        gemm_tile(lds, H, W, DM, DM, brow, bcol, [=](f32x4 c0, f32x4 c1, int row0, int col0) {
          const int cl = col0 - 3584;
          if (cl < 8) {
            const int hh = cl & 3;
#pragma unroll
            for (int j = 0; j < 4; ++j) {
              const int row = row0 + j;
              if (cl < 4) BETA[row * 4 + hh] = 1.f / (1.f + expf(-c0[j]));
              else { float xx = c0[j] + dtb[hh]; float sp = (xx > 20.f) ? xx : log1pf(expf(xx)); Gd[row * 4 + hh] = -expf(alog[hh]) * sp; }
            }
          }
        });
      }
    }
    if (gridDim.x == 256 && oslot >= 975 && oslot < 1024) copy_range(a, 0, 588, oslot - 975, 49, fresh_tid());
  }
  do { if (IN(1) && IN(3)) { xcd_barrier(xb); } } while (0);
  if (IN(3)) {
    int* qctr = (int*)(a.ws + WS_CTL + 6144);
    int* qslot = (int*)(lds + LDS_BYTES - 16);
    const bool ded = (gridDim.x == 256);
    if (ded && blockIdx.x < 16) gdn_scan_item(a, blockIdx.x, lds);
    else for (;;) {
      __syncthreads();
      if (threadIdx.x == 0) *qslot = __hip_atomic_fetch_add(qctr, 1, __ATOMIC_RELAXED, __HIP_MEMORY_SCOPE_AGENT);
      __syncthreads();
      const int q = *qslot;
      if (ded && q >= 2048) {
        const int ci = q - 2048;
        if (ci < 357) {
          const int j0 = 1224 + ci * 8, j1 = (j0 + 8 < 4080) ? j0 + 8 : 4080;
          copy_range(a, j0, j1, 0, 1, fresh_tid());
          continue;
        }
        const int ti = ci - 357;
        if (ti >= (J_T3 - J_T0) / 2) break;
        p0_transpose(a, J_T0 + 2 * ti, lds);
        p0_transpose(a, J_T0 + 2 * ti + 1, lds);
        continue;
      }
      if (q >= 2048 + (ded ? 0 : 16)) break;
      if (q < 1152) {
        const int item = (q < 1024) ? ((q & 15) * 64 + (q >> 4)) : q;
        gdn_prep_item(a, item, lds);
      } else if (q < 1664) attn_item(a, 511 - (q - 1152), lds);
      else if (q < 1920) attn_item(a, 512 + (q - 1664), lds);
      else if (q < 2048) gdn_scan_item(a, 16 + (q - 1920), lds);
      else gdn_scan_item(a, q - 2048, lds);
    }
  }
  SEAM(3);
  if (IN(4)) for (int rep_ = 0; rep_ < NREP(4); ++rep_) {
    const u16* MIX = (const u16*)(a.ws + WS_MIX); const u16* W = (const u16*)(a.ws + WS_WOUT);
    float* X1 = (float*)(a.ws + WS_X1);
    const float* xp = a.in[0]; const float* xs = a.in[1];
    const bool splitk = (gridDim.x == 256);
    int oslot = 0;
    for (int rnd = 0;; ++rnd) {
      int pm, pn; if (!tile_of(rnd, 4, pm, pn, oslot)) break;
      if (splitk && pm == 64) break;
      gemm_tile(lds, MIX, W, DM, DM, pm * 256, pn * 256, [=](f32x4 c0, f32x4 c1, int row0, int col0) {
#pragma unroll
        for (int j = 0; j < 4; ++j) {
          const unsigned o = (unsigned)(row0 + j) * 1024u + (unsigned)col0;
          const float* xb_ = (row0 < NPR) ? xp : (xs - (size_t)NPR * 1024);
          X1[o] = xb_[o] + c0[j];
          X1[o + 16] = xb_[o + 16] + c1[j];
        }
      });
    }
    if (splitk) {
      if (blockIdx.x < 16) {
        const int pn = blockIdx.x & 3, ks = blockIdx.x >> 2;
        float* PART = (float*)(a.ws + WS_PART4) + (size_t)ks * 256 * 1024;
        gemm_tile(lds, MIX + ks * 256, W + ks * 256, 256, DM, 64 * 256, pn * 256, [=](f32x4 c0, f32x4 c1, int row0, int col0) {
#pragma unroll
          for (int j = 0; j < 4; ++j) {
            const size_t o = (size_t)(row0 + j - NPR) * DM + col0;
            PART[o] = c0[j]; PART[o + 16] = c1[j];
          }
        });
      }
    } else { const int ctid = fresh_tid(); for (int jb = blockIdx.x; jb < 2300; jb += gridDim.x) copy_job(a, jb, ctid); }
  }
  SEAM(4);
  if (IN(5)) for (int rep_ = 0; rep_ < NREP(5); ++rep_) {
    const int wave = fresh_tid() >> 6;
    for (int job = blockIdx.x; job < 1040; job += gridDim.x) {
#pragma unroll
      for (int rr = 0; rr < 2; ++rr) {
        int row = job * 16 + wave * 2 + rr;
        float* x1r = (float*)(a.ws + WS_X1) + (size_t)row * DM;
        if (gridDim.x == 256 && row >= NPR) {
          const int ln = fresh_tid() & 63;
          const float* xr = a.in[1] + (size_t)(row - NPR) * DM;
          const float* pp = (const float*)(a.ws + WS_PART4) + (size_t)(row - NPR) * DM;
#pragma unroll
          for (int i = 0; i < 4; ++i) {
            f32x4 v = *reinterpret_cast<const f32x4*>(xr + (i * 64 + ln) * 4);
#pragma unroll
            for (int ks = 0; ks < 4; ++ks) v += *reinterpret_cast<const f32x4*>(pp + (size_t)ks * 256 * 1024 + (i * 64 + ln) * 4);
            *reinterpret_cast<f32x4*>(x1r + (i * 64 + ln) * 4) = v;
          }
        }
        rms_row_bf16<1>(a, x1r, a.in[14], (u16*)(a.ws + WS_H) + (size_t)row * DM, row);
      }
    }
  }
  SEAM(5);
  if (IN(6)) for (int rep_ = 0; rep_ < NREP(6); ++rep_) {
    const u16* H = (const u16*)(a.ws + WS_H); const u16* W = (const u16*)(a.ws + WS_WGU);
    u16* ACT = (u16*)(a.ws + WS_ACT);
    int oslot = 0;
    bool pre = false;
    for (int rnd = 0;; ++rnd) {
      int pm, pn; if (!tile_of(rnd, 22, pm, pn, oslot)) break;
      const int bcol = pn * 256;
      int npm = 0, npn = 0, no_ = 0; const bool hn = tile_of(rnd + 1, 22, npm, npn, no_);
      const bool pre_ = pre; pre = hn;
      gemm_tile(lds, H, W, DM, DM, pm * 256, bcol, [=](f32x4 c0, f32x4 c1, int row0, int col0) {
        const int cl = col0 - bcol; const int f = pn * 128 + (cl >> 7) * 64 + ((cl >> 5) & 3) * 16 + (cl & 15);
        const unsigned o = (unsigned)row0 * 2816u + (unsigned)f;
#pragma unroll
        for (int j = 0; j < 4; ++j) ACT[o + j * 2816] = f2bf(silu_f(c0[j]) * c1[j]);
      }, pre_, hn, npm * 256, npn * 256);
    }
    if (gridDim.x == 256 && oslot >= 1430 && oslot < 1536) copy_range(a, 588, 1224, oslot - 1430, 106, fresh_tid());
  }
  SEAM(6);
  if (IN(7)) for (int rep_ = 0; rep_ < NREP(7); ++rep_) {
    const u16* ACT = (const u16*)(a.ws + WS_ACT); const u16* W = (const u16*)(a.ws + WS_WD);
    const float* X1 = (const float*)(a.ws + WS_X1);
    float* Y = a.out;
    const bool splitk = (gridDim.x == 256);
    int oslot = 0;
    for (int rnd = 0;; ++rnd) {
      int pm, pn; if (!tile_of(rnd, 4, pm, pn, oslot)) break;
      if (splitk && pm == 64) break;
      gemm_tile(lds, ACT, W, DFF, DFF, pm * 256, pn * 256, [=](f32x4 c0, f32x4 c1, int row0, int col0) {
#pragma unroll
        for (int j = 0; j < 4; ++j) {
          const unsigned o = (unsigned)(row0 + j) * 1024u + (unsigned)col0;
          Y[o] = X1[o] + c0[j];
          Y[o + 16] = X1[o + 16] + c1[j];
        }
      });
    }
    if (splitk) {
      if (blockIdx.x < 44) {
        const int pn = blockIdx.x & 3, ks = blockIdx.x >> 2;
        float* PART = (float*)(a.ws + WS_PART7) + (size_t)ks * 256 * 1024;
        gemm_tile(lds, ACT + ks * 256, W + ks * 256, 256, DFF, 64 * 256, pn * 256, [=](f32x4 c0, f32x4 c1, int row0, int col0) {
#pragma unroll
          for (int j = 0; j < 4; ++j) {
            const size_t o = (size_t)(row0 + j - NPR) * DM + col0;
            PART[o] = c0[j]; PART[o + 16] = c1[j];
          }
        });
      }
    } else { const int ctid = fresh_tid(); for (int jb = 2300 + blockIdx.x; jb < 4080; jb += gridDim.x) copy_job(a, jb, ctid); }
  }
  SEAM(7);
  if (IN(8)) for (int rep_ = 0; rep_ < NREP(8); ++rep_) {
    const int tid = fresh_tid(), lane = tid & 63, wave = tid >> 6;
    for (int job = blockIdx.x; job < 1040; job += gridDim.x) {
      float* yr0 = a.out + (size_t)(job * 16 + wave * 2) * DM;
      f32x4 x[2][4]; float ss[2] = {0.f, 0.f};
#pragma unroll
      for (int rr = 0; rr < 2; ++rr) {
        const int row = job * 16 + wave * 2 + rr;
        if (gridDim.x == 256 && row >= NPR) {
          const float* x1r = (const float*)(a.ws + WS_X1) + (size_t)row * DM;
          const float* pp = (const float*)(a.ws + WS_PART7) + (size_t)(row - NPR) * DM;
#pragma unroll
          for (int i = 0; i < 4; ++i) {
            f32x4 v = *reinterpret_cast<const f32x4*>(x1r + (i * 64 + lane) * 4);
#pragma unroll
            for (int ks = 0; ks < 11; ++ks) v += *reinterpret_cast<const f32x4*>(pp + (size_t)ks * 256 * 1024 + (i * 64 + lane) * 4);
            x[rr][i] = v;
          }
        } else {
#pragma unroll
          for (int i = 0; i < 4; ++i) x[rr][i] = *reinterpret_cast<const f32x4*>(yr0 + rr * DM + (i * 64 + lane) * 4);
        }
      }
#pragma unroll
      for (int rr = 0; rr < 2; ++rr) {
#pragma unroll
        for (int i = 0; i < 4; ++i) ss[rr] += x[rr][i][0] * x[rr][i][0] + x[rr][i][1] * x[rr][i][1] + x[rr][i][2] * x[rr][i][2] + x[rr][i][3] * x[rr][i][3];
        ss[rr] = wave_sum(ss[rr]);
      }
#pragma unroll
      for (int rr = 0; rr < 2; ++rr) {
        const float rstd = rsqrtf(ss[rr] * (1.f / 1024.f) + EPS);
#pragma unroll
        for (int i = 0; i < 4; ++i) {
          f32x4 wv = *reinterpret_cast<const f32x4*>(a.in[18] + (i * 64 + lane) * 4);
          f32x4 y;
          y[0] = x[rr][i][0] * rstd * wv[0]; y[1] = x[rr][i][1] * rstd * wv[1]; y[2] = x[rr][i][2] * rstd * wv[2]; y[3] = x[rr][i][3] * rstd * wv[3];
          *reinterpret_cast<f32x4*>(yr0 + rr * DM + (i * 64 + lane) * 4) = y;
        }
      }
    }
  }
#undef IN
#undef SEAM
}

extern "C" void kernel_launch(void* const* d_in, const int* in_sizes, int n_in, void* d_out, int out_size,
                              void* d_ws, size_t ws_size, hipStream_t stream) {
  static int grid = 0;
  if (grid == 0) {
    if (n_in != 19 || (size_t)out_size != O_END || ws_size < WS_END) {
      fprintf(stderr, "kernel_launch: unexpected shapes n_in %d out %d ws %zu (need %zu)\n", n_in, out_size, ws_size, (size_t)WS_END);
      grid = -1; return;
    }
    int dev = 0, cus = 0, per_cu = 0;
    hipGetDevice(&dev);
    hipDeviceGetAttribute(&cus, hipDeviceAttributeMultiprocessorCount, dev);
    if (hipFuncSetAttribute((const void*)fwd_kernel, hipFuncAttributeMaxDynamicSharedMemorySize, LDS_BYTES) != hipSuccess) {
      fprintf(stderr, "kernel_launch: hipFuncSetAttribute failed\n"); grid = -1; return;
    }
    hipOccupancyMaxActiveBlocksPerMultiprocessor(&per_cu, (const void*)fwd_kernel, NTHR, LDS_BYTES);
    if (per_cu < 1) per_cu = 1;
    grid = cus * per_cu;
    (void)hipGetLastError();
  }
  if (grid < 0) return;
  if (hipMemsetAsync((char*)d_ws + WS_CTL, 0, 32768, stream) != hipSuccess) { fprintf(stderr, "kernel_launch: memset of the ready flags failed\n"); return; }
  Args a{};
  for (int i = 0; i < 19; ++i) a.in[i] = (const float*)d_in[i];
  a.out = (float*)d_out; a.ws = (unsigned char*)d_ws;
#if ONE_LAUNCH
  a.ph_lo = 0; a.ph_hi = 9;
  void* args[] = {&a};
  hipError_t e = hipLaunchCooperativeKernel((const void*)fwd_kernel, dim3(grid), dim3(NTHR), args, LDS_BYTES, stream);
  if (e != hipSuccess) fprintf(stderr, "cooperative launch failed: %s (grid %d)\n", hipGetErrorString(e), grid);
#else
  for (int p = 0; p < 9; ++p) {
    if (p == 2) continue;
    a.ph_lo = p; a.ph_hi = p + 1;
    hipLaunchKernelGGL(fwd_kernel, dim3(grid), dim3(NTHR), LDS_BYTES, stream, a);
  }
#endif
}
```

```cpp
#include <hip/hip_runtime.h>
#include <hip/hip_cooperative_groups.h>
#include <cstdio>
namespace cg = cooperative_groups;

#ifndef ONE_LAUNCH
#define ONE_LAUNCH 1
#endif

typedef unsigned short u16;
typedef __attribute__((ext_vector_type(8))) short bf16x8;
typedef __attribute__((ext_vector_type(4))) short bf16x4;
typedef __attribute__((ext_vector_type(4))) float f32x4;
typedef __attribute__((ext_vector_type(2))) float f32x2;

constexpr int DM = 1024, NPR = 16384, NSM = 256, NT = 16640, SEQ = 4096;
constexpr int CONVD = 1536, INC = 3592, NPROJ = 3584, DFF = 2816, NGU = 5632;
constexpr float EPS = 1e-6f;
constexpr size_t O_Y = 0;
constexpr size_t O_CONVP = (size_t)NT * DM;
constexpr size_t O_RECP = O_CONVP + 4 * 3 * 1536;
constexpr size_t O_WKP = O_RECP + 4 * 4 * 128 * 128;
constexpr size_t O_WVP = O_WKP + (size_t)4 * 2048 * 512;
constexpr size_t O_CONVS = O_WVP + (size_t)4 * 2048 * 512;
constexpr size_t O_RECS = O_CONVS + 32 * 3 * 1536;
constexpr size_t O_WKS = O_RECS + (size_t)32 * 4 * 128 * 128;
constexpr size_t O_WVS = O_WKS + (size_t)32 * 2048 * 512;
constexpr size_t O_END = O_WVS + (size_t)32 * 2048 * 512;
constexpr size_t WS_CTL = 0;
constexpr size_t WS_BAR = 8192;
constexpr size_t WS_WIN = 32768;
constexpr int NPROJP = 3840;
constexpr size_t WS_WOUT = WS_WIN + (size_t)NPROJP * DM * 2;
constexpr size_t WS_WGU = WS_WOUT + (size_t)DM * DM * 2;
constexpr size_t WS_WD = WS_WGU + (size_t)NGU * DM * 2;
constexpr size_t WS_H = WS_WD + (size_t)DM * DFF * 2;
constexpr size_t WS_QKVA = WS_H + (size_t)NT * DM * 2;
constexpr size_t WS_Z = WS_QKVA + (size_t)NT * CONVD * 2;
constexpr size_t WS_QB = WS_Z + (size_t)NT * 512 * 2;
constexpr size_t WS_KB = WS_QB + (size_t)NT * 512 * 2;
constexpr size_t WS_VB = WS_KB + (size_t)NT * 512 * 2;
constexpr size_t WS_BETA = WS_VB + (size_t)NT * 512 * 2;
constexpr size_t WS_G = WS_BETA + (size_t)NT * 4 * 4;
constexpr size_t GREC = 73728;
constexpr int NREC = 1152;
constexpr size_t WS_GDN = WS_G + (size_t)NT * 4 * 4;
constexpr size_t WS_EGL = WS_GDN + (size_t)NREC * GREC;
constexpr size_t WS_MIX = WS_EGL + 8192;
constexpr size_t WS_X1 = WS_MIX + (size_t)NT * DM * 2;
constexpr size_t WS_ACT = WS_X1 + (size_t)NT * DM * 4;
constexpr size_t WS_PART4 = WS_ACT + (size_t)NT * DFF * 2;
constexpr size_t WS_PART7 = WS_PART4 + (size_t)4 * 256 * 1024 * 4;
constexpr size_t WS_END = WS_PART7 + (size_t)11 * 256 * 1024 * 4;

constexpr int LDS_BYTES = 163840;
constexpr int NTHR = 512;

struct Args { const float* in[19]; float* out; unsigned char* ws; int ph_lo, ph_hi; };

__device__ __forceinline__ int fresh_tid() { int t = threadIdx.x; asm volatile("" : "+v"(t)); return t; }
typedef __attribute__((ext_vector_type(2))) __bf16 hbf2;
typedef __attribute__((ext_vector_type(4))) unsigned u32x4;
__device__ __forceinline__ unsigned pack2(float a, float b) {
  f32x2 v; v[0] = a; v[1] = b;
  hbf2 r = __builtin_convertvector(v, hbf2);
  return __builtin_bit_cast(unsigned, r);
}
__device__ __forceinline__ u16 f2bf(float f) { return (u16)(pack2(f, 0.f) & 0xffffu); }
__device__ __forceinline__ float bf2f(u16 h) { return __uint_as_float(((unsigned)h) << 16); }
__device__ __forceinline__ float bflo(unsigned u) { return __uint_as_float(u << 16); }
__device__ __forceinline__ float bfhi(unsigned u) { return __uint_as_float(u & 0xffff0000u); }
__device__ __forceinline__ float silu_f(float x) { return x * __builtin_amdgcn_rcpf(1.f + __expf(-x)); }
__device__ __forceinline__ bf16x8 pack8(f32x4 a, f32x4 b) {
  u32x4 r; r[0] = pack2(a[0], a[1]); r[1] = pack2(a[2], a[3]); r[2] = pack2(b[0], b[1]); r[3] = pack2(b[2], b[3]);
  return __builtin_bit_cast(bf16x8, r);
}
__device__ __forceinline__ float wave_sum(float v) {
  v += __shfl_xor(v, 1); v += __shfl_xor(v, 2); v += __shfl_xor(v, 4);
  v += __shfl_xor(v, 8); v += __shfl_xor(v, 16); v += __shfl_xor(v, 32);
  return v;
}

constexpr int BM = 256, BK = 64, HALF = 128, HT = HALF * BK;
__device__ __forceinline__ int lds_byte(int r, int c) {
  int st = (r >> 4) * 2 + (c >> 5), rr = r & 15, cc = c & 31, ob = rr * 64 + cc * 2;
  return st * 1024 + (ob ^ (((ob >> 9) & 1) << 5));
}
__device__ __forceinline__ void stage_rc(int b, int& R, int& C) {
  int st = b / 1024, sb = b % 1024, swz = sb ^ (((sb >> 9) & 1) << 5);
  R = (st >> 1) * 16 + swz / 64; C = (st & 1) * 32 + (swz % 64) / 2;
}

template <class Epi>
__device__ __forceinline__ void gemm_tile(unsigned char* ldsraw, const u16* __restrict__ A, const u16* __restrict__ Bt,
                                          const int K, const int ldk, const int brow, const int bcol, Epi epi) {
  u16* shm = (u16*)ldsraw;
  const int gtid = fresh_tid();
#define SA(b, h) (shm + ((b) * 2 + (h)) * HT)
#define SB(b, h) (shm + (4 + (b) * 2 + (h)) * HT)
#define STAGE(P, BASE, br, kt) do { const u16* _gp = (BASE) + (long)(br) * ldk + (long)(kt) * BK; \
    __builtin_amdgcn_global_load_lds((const unsigned*)(_gp + soff0), (__attribute__((address_space(3))) unsigned*)((char*)(P) + gtid * 16), 16, 0, 0); \
    __builtin_amdgcn_global_load_lds((const unsigned*)(_gp + soff1), (__attribute__((address_space(3))) unsigned*)((char*)(P) + gtid * 16 + 8192), 16, 0, 0); } while (0)
#define LDA(dst, b, h) for (int m = 0; m < 4; ++m) for (int k = 0; k < 2; ++k) \
    dst[m][k] = *reinterpret_cast<const bf16x8*>((char*)SA(b, h) + lds_byte(wr * 64 + m * 16 + fr, k * 32 + fq * 8))
#define LDB(dst, b, h) for (int n = 0; n < 2; ++n) for (int k = 0; k < 2; ++k) \
    dst[n][k] = *reinterpret_cast<const bf16x8*>((char*)SB(b, h) + lds_byte(wc * 32 + n * 16 + fr, k * 32 + fq * 8))
#define MMA(ai, bj, At_, Bt_) do { __builtin_amdgcn_s_setprio(1); \
    for (int m = 0; m < 4; ++m) for (int n = 0; n < 2; ++n) for (int k = 0; k < 2; ++k) \
      acc[ai][bj][m][n] = __builtin_amdgcn_mfma_f32_16x16x32_bf16(At_[m][k], Bt_[n][k], acc[ai][bj][m][n], 0, 0, 0); \
    __builtin_amdgcn_s_setprio(0); } while (0)
#define WAIT_V(n) asm volatile("s_waitcnt vmcnt(" #n ")" ::: "memory")
#define WAIT_L(n) asm volatile("s_waitcnt lgkmcnt(" #n ")" ::: "memory")
#define BAR __builtin_amdgcn_s_barrier()
#define SCHED __builtin_amdgcn_sched_barrier(0)
  const int wid = gtid >> 6, lane = gtid & 63, wr = wid >> 2, wc = wid & 3, fr = lane & 15, fq = lane >> 4;
  int soff0, soff1;
  { int r_, c_; stage_rc(gtid * 16, r_, c_); soff0 = r_ * ldk + c_; stage_rc(gtid * 16 + 8192, r_, c_); soff1 = r_ * ldk + c_; }
  f32x4 acc[2][2][4][2];
#pragma unroll
  for (int i0 = 0; i0 < 2; ++i0)
#pragma unroll
    for (int i1 = 0; i1 < 2; ++i1)
#pragma unroll
      for (int i2 = 0; i2 < 4; ++i2)
#pragma unroll
        for (int i3 = 0; i3 < 2; ++i3) acc[i0][i1][i2][i3] = (f32x4){0.f, 0.f, 0.f, 0.f};
  bf16x8 At[4][2], B0[2][2], B1[2][2];
  const int nt = K / BK;
  STAGE(SB(0, 0), Bt, bcol, 0); STAGE(SA(0, 0), A, brow, 0);
  STAGE(SB(0, 1), Bt, bcol + HALF, 0); STAGE(SA(0, 1), A, brow + HALF, 0);
  if (wr == 1) BAR;
  WAIT_V(4); BAR;
  STAGE(SB(1, 0), Bt, bcol, 1); STAGE(SA(1, 0), A, brow, 1); STAGE(SB(1, 1), Bt, bcol + HALF, 1);
  WAIT_V(6); BAR;
  for (int t = 0; t < nt - 2; t += 2) {
    LDB(B0, 0, 0); SCHED; LDA(At, 0, 0); STAGE(SA(1, 1), A, brow + HALF, t + 1);
    WAIT_L(8); BAR; WAIT_L(0); MMA(0, 0, At, B0); BAR; SCHED;
    LDB(B1, 0, 1); STAGE(SB(0, 0), Bt, bcol, t + 2);
    BAR; WAIT_L(0); MMA(0, 1, At, B1); BAR;
    LDA(At, 0, 1); STAGE(SA(0, 0), A, brow, t + 2);
    BAR; WAIT_L(0); MMA(1, 0, At, B0); BAR; SCHED;
    STAGE(SB(0, 1), Bt, bcol + HALF, t + 2);
    WAIT_V(6); BAR; MMA(1, 1, At, B1); BAR;
    LDB(B0, 1, 0); SCHED; LDA(At, 1, 0); STAGE(SA(0, 1), A, brow + HALF, t + 2);
    WAIT_L(8); BAR; WAIT_L(0); MMA(0, 0, At, B0); BAR; SCHED;
    LDB(B1, 1, 1); STAGE(SB(1, 0), Bt, bcol, t + 3);
    BAR; WAIT_L(0); MMA(0, 1, At, B1); BAR;
    LDA(At, 1, 1); STAGE(SA(1, 0), A, brow, t + 3);
    BAR; WAIT_L(0); MMA(1, 0, At, B0); BAR; SCHED;
    STAGE(SB(1, 1), Bt, bcol + HALF, t + 3);
    WAIT_V(6); BAR; MMA(1, 1, At, B1); BAR;
  }
  { LDB(B0, 0, 0); LDA(At, 0, 0); STAGE(SA(1, 1), A, brow + HALF, nt - 1);
    BAR; WAIT_L(0); MMA(0, 0, At, B0); BAR;
    LDB(B1, 0, 1); BAR; WAIT_L(0); MMA(0, 1, At, B1); BAR;
    LDA(At, 0, 1); WAIT_V(4); BAR; WAIT_L(0); MMA(1, 0, At, B0); MMA(1, 1, At, B1); BAR; }
  { LDB(B0, 1, 0); LDA(At, 1, 0); WAIT_V(2); BAR; WAIT_L(0); MMA(0, 0, At, B0); BAR;
    LDB(B1, 1, 1); WAIT_V(0); BAR; WAIT_L(0); MMA(0, 1, At, B1); BAR;
    LDA(At, 1, 1); BAR; WAIT_L(0); MMA(1, 0, At, B0); MMA(1, 1, At, B1); BAR; }
  if (wr == 0) BAR;
#pragma unroll
  for (int ai = 0; ai < 2; ++ai)
#pragma unroll
    for (int bj = 0; bj < 2; ++bj)
#pragma unroll
      for (int m = 0; m < 4; ++m) {
        const int row0 = brow + ai * HALF + wr * 64 + m * 16 + fq * 4;
        const int col0 = bcol + bj * HALF + wc * 32 + fr;
        epi(acc[ai][bj][m][0], acc[ai][bj][m][1], row0, col0);
      }
  __syncthreads();
#undef SA
#undef SB
#undef STAGE
#undef LDA
#undef LDB
#undef MMA
}

constexpr int J_T0 = 480, J_T1 = J_T0 + 128, J_T2 = J_T1 + 704, J_T3 = J_T2 + 352;
constexpr int J_RMS = J_T3 + 1040;

__device__ __forceinline__ void p0_transpose(const Args& a, int job, unsigned char* lds) {
  float* tile = (float*)lds;
  const int tid = fresh_tid();
  int mat, nt_, kt_;
  if (job < J_T0) { mat = 0; nt_ = job / 16; kt_ = job % 16; }
  else if (job < J_T1) { mat = 1; int j = job - J_T0; nt_ = j / 16; kt_ = j % 16; }
  else if (job < J_T2) { mat = 2; int j = job - J_T1; nt_ = j / 16; kt_ = j % 16; }
  else { mat = 3; int j = job - J_T2; nt_ = j / 44; kt_ = j % 44; }
  const int n0 = nt_ * 128, k0 = kt_ * 64;
  const float* src; int ld, Kd; u16* dst;
  if (mat == 0) { src = a.in[7]; ld = INC; Kd = DM; dst = (u16*)(a.ws + WS_WIN); }
  else if (mat == 1) { src = a.in[13]; ld = DM; Kd = DM; dst = (u16*)(a.ws + WS_WOUT); }
  else if (mat == 2) { src = a.in[15]; ld = DFF; Kd = DM; dst = (u16*)(a.ws + WS_WGU); }
  else { src = a.in[17]; ld = DM; Kd = DFF; dst = (u16*)(a.ws + WS_WD); }
  float vals[16];
#pragma unroll
  for (int i = 0; i < 16; ++i) {
    int e = tid + 512 * i; int kl = e >> 7, nl = e & 127; int n = n0 + nl; int col; const float* s = src;
    bool zero_ = false;
    if (mat == 0) { if (n < 2048) col = n; else if (n < 3584) col = n + 8; else if (n < 3592) col = 2048 + (n - 3584); else { col = 0; zero_ = true; } }
    else if (mat == 2) { int t256 = n >> 8, bj = (n >> 7) & 1, wc = (n >> 5) & 3, nn = (n >> 4) & 1, fr = n & 15;
      col = t256 * 128 + bj * 64 + wc * 16 + fr; if (nn) s = a.in[16]; }
    else col = n;
    vals[i] = zero_ ? 0.f : s[(size_t)(k0 + kl) * ld + col];
  }
#pragma unroll
  for (int i = 0; i < 16; ++i) { int e = tid + 512 * i; tile[(e >> 7) * 129 + (e & 127)] = vals[i]; }
  __syncthreads();
  {
    int nl = tid >> 2, k16 = (tid & 3) * 16;
    bf16x8 v0, v1;
#pragma unroll
    for (int i = 0; i < 8; ++i) { v0[i] = (short)f2bf(tile[(k16 + i) * 129 + nl]); v1[i] = (short)f2bf(tile[(k16 + 8 + i) * 129 + nl]); }
    bf16x8* dp = reinterpret_cast<bf16x8*>(dst + (size_t)(n0 + nl) * Kd + k0 + k16);
    dp[0] = v0; dp[1] = v1;
  }
  __syncthreads();
}

template <int MODE>
__device__ __forceinline__ void rms_row_bf16(const Args& a, const float* __restrict__ xrow, const float* __restrict__ nw,
                                             u16* __restrict__ hrow, int row) {
  const int lane = fresh_tid() & 63;
  f32x4 x[4];
  float ss = 0.f;
#pragma unroll
  for (int i = 0; i < 4; ++i) {
    x[i] = *reinterpret_cast<const f32x4*>(xrow + (i * 64 + lane) * 4);
    ss += x[i][0] * x[i][0] + x[i][1] * x[i][1] + x[i][2] * x[i][2] + x[i][3] * x[i][3];
  }
  ss = wave_sum(ss);
  const float rstd = rsqrtf(ss * (1.f / 1024.f) + EPS);
  float dot[8];
  if (MODE == 0) {
#pragma unroll
    for (int c = 0; c < 8; ++c) dot[c] = 0.f;
  }
#pragma unroll
  for (int i = 0; i < 4; ++i) {
    f32x4 w = *reinterpret_cast<const f32x4*>(nw + (i * 64 + lane) * 4);
    f32x4 h;
    h[0] = x[i][0] * rstd * w[0]; h[1] = x[i][1] * rstd * w[1]; h[2] = x[i][2] * rstd * w[2]; h[3] = x[i][3] * rstd * w[3];
    uint2 pk; pk.x = pack2(h[0], h[1]); pk.y = pack2(h[2], h[3]);
    *reinterpret_cast<uint2*>(hrow + (i * 64 + lane) * 4) = pk;
    if (MODE == 0) {
      const float* wi = a.in[7];
#pragma unroll
      for (int e = 0; e < 4; ++e) {
        int k = (i * 64 + lane) * 4 + e;
        f32x4 w0 = *reinterpret_cast<const f32x4*>(wi + (size_t)k * INC + 2048);
        f32x4 w1 = *reinterpret_cast<const f32x4*>(wi + (size_t)k * INC + 2052);
        dot[0] += h[e] * w0[0]; dot[1] += h[e] * w0[1]; dot[2] += h[e] * w0[2]; dot[3] += h[e] * w0[3];
        dot[4] += h[e] * w1[0]; dot[5] += h[e] * w1[1]; dot[6] += h[e] * w1[2]; dot[7] += h[e] * w1[3];
      }
    }
  }
  if (MODE == 0) {
#pragma unroll
    for (int c = 0; c < 8; ++c) dot[c] = wave_sum(dot[c]);
    float* BETA = (float*)(a.ws + WS_BETA); float* G = (float*)(a.ws + WS_G);
    if (lane < 4) {
      float bv = (lane == 0) ? dot[0] : (lane == 1) ? dot[1] : (lane == 2) ? dot[2] : dot[3];
      float av = (lane == 0) ? dot[4] : (lane == 1) ? dot[5] : (lane == 2) ? dot[6] : dot[7];
      float beta = 1.f / (1.f + expf(-bv));
      float xx = av + a.in[10][lane];
      float sp = (xx > 20.f) ? xx : log1pf(expf(xx));
      float g = -expf(a.in[9][lane]) * sp;
      BETA[row * 4 + lane] = beta; G[row * 4 + lane] = g;
    }
  }
}

__device__ __forceinline__ void phase0(const Args& a, unsigned char* lds) {
  const int tid = fresh_tid(), wave = tid >> 6;
  const bool defer = (gridDim.x == 256);
  for (int job = blockIdx.x; job < J_RMS; job += gridDim.x) {
    if (defer && job >= J_T0 && job < J_T3) continue;
    if (job < J_T3) p0_transpose(a, job, lds);
    else {
#pragma unroll
      for (int rr = 0; rr < 2; ++rr) {
        int row = (job - J_T3) * 16 + wave * 2 + rr;
        const float* xr = (row < NPR) ? a.in[0] + (size_t)row * DM : a.in[1] + (size_t)(row - NPR) * DM;
        rms_row_bf16<1>(a, xr, a.in[6], (u16*)(a.ws + WS_H) + (size_t)row * DM, row);
      }
    }
  }
}
__device__ __forceinline__ void copy_range(const Args& a, int j0, int j1, int first, int stride, int tid);
__device__ __forceinline__ void copy_job(const Args& a, int jb, int tid) {
#pragma unroll
  for (int i = 0; i < 8; ++i) {
    int idx = jb * 4096 + i * 512 + tid;
    int ab = idx / 261120, off = idx - ab * 261120;
    int arr = ab >> 5, b = ab & 31;
    const float* src = (arr ? a.in[5] : a.in[4]) + (size_t)b * 1048576 + 4096 + (size_t)off * 4;
    float* dst = a.out + (arr ? O_WVS : O_WKS) + (size_t)b * 1048576 + (size_t)off * 4;
    f32x4 v = __builtin_nontemporal_load(reinterpret_cast<const f32x4*>(src));
    __builtin_nontemporal_store(v, reinterpret_cast<f32x4*>(dst));
  }
}

__device__ __forceinline__ void copy_range(const Args& a, int j0, int j1, int first, int stride, int tid) {
  int jb = j0 + first;
  for (; jb + stride < j1; jb += 2 * stride) {
    f32x4 v[16];
#pragma unroll
    for (int i = 0; i < 16; ++i) {
      int idx = ((i < 8) ? jb : jb + stride) * 4096 + (i & 7) * 512 + tid;
      int ab = idx / 261120, off = idx - ab * 261120; int arr = ab >> 5, b = ab & 31;
      const float* src = (arr ? a.in[5] : a.in[4]) + (size_t)b * 1048576 + 4096 + (size_t)off * 4;
      v[i] = __builtin_nontemporal_load(reinterpret_cast<const f32x4*>(src));
    }
#pragma unroll
    for (int i = 0; i < 16; ++i) {
      int idx = ((i < 8) ? jb : jb + stride) * 4096 + (i & 7) * 512 + tid;
      int ab = idx / 261120, off = idx - ab * 261120; int arr = ab >> 5, b = ab & 31;
      float* dst = a.out + (arr ? O_WVS : O_WKS) + (size_t)b * 1048576 + (size_t)off * 4;
      __builtin_nontemporal_store(v[i], reinterpret_cast<f32x4*>(dst));
    }
  }
  if (jb < j1) copy_job(a, jb, tid);
}
typedef unsigned long long u64;
__device__ __forceinline__ void st_wt16(void* p, bf16x8 v) {
  typedef __attribute__((ext_vector_type(2))) u64 u64x2;
  u64x2 q = __builtin_bit_cast(u64x2, v);
  __hip_atomic_store((u64*)p, q[0], __ATOMIC_RELAXED, __HIP_MEMORY_SCOPE_AGENT);
  __hip_atomic_store((u64*)p + 1, q[1], __ATOMIC_RELAXED, __HIP_MEMORY_SCOPE_AGENT);
}
__device__ __forceinline__ void st_wt8(void* p, bf16x4 v) {
  __hip_atomic_store((u64*)p, __builtin_bit_cast(u64, v), __ATOMIC_RELAXED, __HIP_MEMORY_SCOPE_AGENT);
}
template <class G>
__device__ __forceinline__ void emit_frag(bf16x8* __restrict__ dst, int nR, int nKs, G get) {
  const int total = nR * nKs * 64;
  for (int idx = fresh_tid(); idx < total; idx += NTHR) {
    int f = idx >> 6, l = idx & 63; int R = f / nKs, ks = f - R * nKs; int m = l & 15, kg = l >> 4;
    int row = 16 * R + m, c0 = 32 * ks + 4 * kg;
    bf16x8 v;
#pragma unroll
    for (int j = 0; j < 4; ++j) { v[j] = (short)f2bf(get(row, c0 + j)); v[4 + j] = (short)f2bf(get(row, c0 + 16 + j)); }
    st_wt16(dst + idx, v);
  }
}

__device__ __forceinline__ void gdn_prep_item(const Args& a, int item, unsigned char* lds) {
  float* Kf = (float*)lds;
  float* Qf = Kf + 64 * 132;
  float* Vb = Qf + 64 * 132;
  float* Lm = Vb + 64 * 132;
  float* QKm = Lm + 64 * 68;
  float* gc = QKm + 64 * 68;
  float* bet = gc + 64;
  float* gg = bet + 64;
  float* Ti = gg + 64;
  const int tid = fresh_tid(), lane = tid & 63, wave = tid >> 6;
  const bool samp = item >= 1024;
  int b, h, ch, row0, ntok;
  if (!samp) { int bh = item >> 6; ch = item & 63; b = bh >> 2; h = bh & 3; row0 = b * SEQ + ch * 64; ntok = 64; }
  else { int s = item - 1024; b = s >> 2; h = s & 3; ch = 0; row0 = NPR + b * 8; ntok = 8; }
  const u16* QKVA = (const u16*)(a.ws + WS_QKVA);
  const float* BETA = (const float*)(a.ws + WS_BETA);
  const float* Gg = (const float*)(a.ws + WS_G);
  unsigned char* rec = a.ws + WS_GDN + (size_t)item * GREC;
  {
    const int t0 = wave * 8;
    float betv[8];
#pragma unroll
    for (int i = 0; i < 8; ++i) {
      const int t = t0 + i; float be = 0.f, g = 0.f;
      if (t < ntok) { be = BETA[(row0 + t) * 4 + h]; g = Gg[(row0 + t) * 4 + h]; }
      betv[i] = be;
      if (lane == 0) { bet[t] = be; gg[t] = g; }
    }
#pragma unroll
    for (int seg = 0; seg < 3; ++seg) {
      const int cb = seg * 512 + h * 128 + 2 * lane;
      float* dstm = (seg == 0) ? Qf : (seg == 1) ? Kf : Vb;
      float w0[4], w1[4];
#pragma unroll
      for (int i = 0; i < 4; ++i) { f32x2 ww = *reinterpret_cast<const f32x2*>(a.in[8] + i * CONVD + cb); w0[i] = ww[0]; w1[i] = ww[1]; }
      float r0[11], r1[11];
#pragma unroll
      for (int i = 0; i < 11; ++i) {
        int tk = t0 - 3 + i;
        float v0 = 0.f, v1 = 0.f;
        if (!samp) {
          int pos = ch * 64 + tk;
          if (pos >= 0) { unsigned u = *reinterpret_cast<const unsigned*>(QKVA + (size_t)(b * SEQ + pos) * CONVD + cb); v0 = bflo(u); v1 = bfhi(u); }
        } else {
          if (tk < 0) { f32x2 sv = *reinterpret_cast<const f32x2*>(a.in[2] + (size_t)(b * 3 + 3 + tk) * CONVD + cb); v0 = sv[0]; v1 = sv[1]; }
          else if (tk < 8) { unsigned u = *reinterpret_cast<const unsigned*>(QKVA + (size_t)(NPR + b * 8 + tk) * CONVD + cb); v0 = bflo(u); v1 = bfhi(u); }
        }
        r0[i] = v0; r1[i] = v1;
      }
#pragma unroll
      for (int i = 0; i < 8; ++i) {
        const int t = t0 + i;
        float c0 = silu_f(r0[i] * w0[0] + r0[i + 1] * w0[1] + r0[i + 2] * w0[2] + r0[i + 3] * w0[3]);
        float c1 = silu_f(r1[i] * w1[0] + r1[i + 1] * w1[1] + r1[i + 2] * w1[2] + r1[i + 3] * w1[3]);
        float sc = (t < ntok) ? ((seg == 2) ? betv[i] : 1.f) : 0.f;
        f32x2 o2; o2[0] = c0 * sc; o2[1] = c1 * sc;
        *reinterpret_cast<f32x2*>(dstm + t * 132 + 2 * lane) = o2;
      }
    }
  }
  __syncthreads();
  {
    const int tok = tid >> 3, part = tid & 7;
    float* qp = Qf + tok * 132 + 16 * part; float* kp = Kf + tok * 132 + 16 * part;
    f32x4 qv[4], kv[4]; float sq = 0.f, sk = 0.f;
#pragma unroll
    for (int i = 0; i < 4; ++i) {
      qv[i] = *reinterpret_cast<const f32x4*>(qp + 4 * i); kv[i] = *reinterpret_cast<const f32x4*>(kp + 4 * i);
      sq += qv[i][0] * qv[i][0] + qv[i][1] * qv[i][1] + qv[i][2] * qv[i][2] + qv[i][3] * qv[i][3];
      sk += kv[i][0] * kv[i][0] + kv[i][1] * kv[i][1] + kv[i][2] * kv[i][2] + kv[i][3] * kv[i][3];
    }
    sq += __shfl_xor(sq, 1); sq += __shfl_xor(sq, 2); sq += __shfl_xor(sq, 4);
    sk += __shfl_xor(sk, 1); sk += __shfl_xor(sk, 2); sk += __shfl_xor(sk, 4);
    const float rq = rsqrtf(sq + EPS) * 0.08838834764831845f, rk = rsqrtf(sk + EPS);
#pragma unroll
    for (int i = 0; i < 4; ++i) {
      *reinterpret_cast<f32x4*>(qp + 4 * i) = qv[i] * rq;
      *reinterpret_cast<f32x4*>(kp + 4 * i) = kv[i] * rk;
    }
    if (wave == 0) {
      float x = gg[lane];
#pragma unroll
      for (int off = 1; off < 64; off <<= 1) { float y = __shfl_up(x, off); if (lane >= off) x += y; }
      gc[lane] = x;
    }
  }
  __syncthreads();
  {
    const int m = lane & 15, kq = lane >> 4;
    const int ct = wave >> 1;
#pragma unroll
    for (int ss = 0; ss < 2; ++ss) {
      const int st = (wave & 1) * 2 + ss;
      f32x4 akk = (f32x4){0.f, 0.f, 0.f, 0.f}, aqk = (f32x4){0.f, 0.f, 0.f, 0.f};
      if (st <= ct) {
        const float* kap = Kf + (16 * ct + m) * 132 + 4 * kq;
        const float* qap = Qf + (16 * ct + m) * 132 + 4 * kq;
        const float* kbp = Kf + (16 * st + m) * 132 + 4 * kq;
#pragma unroll
        for (int blk = 0; blk < 8; ++blk) {
          f32x4 ka = *reinterpret_cast<const f32x4*>(kap + 16 * blk);
          f32x4 qa = *reinterpret_cast<const f32x4*>(qap + 16 * blk);
          f32x4 kb = *reinterpret_cast<const f32x4*>(kbp + 16 * blk);
#pragma unroll
          for (int t = 0; t < 4; ++t) {
            akk = __builtin_amdgcn_mfma_f32_16x16x4f32(ka[t], kb[t], akk, 0, 0, 0);
            aqk = __builtin_amdgcn_mfma_f32_16x16x4f32(qa[t], kb[t], aqk, 0, 0, 0);
          }
        }
      }
      const int s = 16 * st + m;
      const float gcs = gc[s];
#pragma unroll
      for (int j = 0; j < 4; ++j) {
        const int c = 16 * ct + 4 * kq + j;
        float arg = (s <= c) ? (gc[c] - gcs) : 0.f;
        float dec = __expf(arg);
        Lm[c * 68 + s] = (s < c) ? bet[c] * akk[j] * dec : 0.f;
        QKm[c * 68 + s] = (s <= c) ? aqk[j] * dec : 0.f;
      }
    }
  }
  __syncthreads();
  {
    const float gl = gc[63];
    emit_frag((bf16x8*)(rec + 16384), 4, 4, [&](int row, int col) { return Qf[row * 132 + col] * __expf(gc[row]); });
    emit_frag((bf16x8*)(rec + 32768), 8, 2, [&](int row, int col) { return Kf[col * 132 + row] * __expf(gl - gc[col]); });
    emit_frag((bf16x8*)(rec + 49152), 4, 2, [&](int row, int col) { return QKm[row * 68 + col]; });
    if (tid >= 64 && tid < 128) { f32x4 e4 = (f32x4){__expf(gl), __expf(gl), __expf(gl), __expf(gl)}; st_wt16(rec + 49152 + 1024 + (tid - 64) * 16, __builtin_bit_cast(bf16x8, e4)); }
  }
  __syncthreads();
  if (wave == 0) {
    const int blk = lane >> 4, jc = lane & 15;
    float x[16];
#pragma unroll
    for (int r = 0; r < 16; ++r) x[r] = 0.f;
#pragma unroll
    for (int r = 0; r < 16; ++r) {
      float acc = (r == jc) ? 1.f : 0.f;
#pragma unroll
      for (int q = 0; q < (r + 3) / 4; ++q) {
        f32x4 l4 = *reinterpret_cast<const f32x4*>(Lm + (16 * blk + r) * 68 + 16 * blk + 4 * q);
        acc -= l4[0] * x[4 * q] + l4[1] * x[4 * q + 1] + l4[2] * x[4 * q + 2] + l4[3] * x[4 * q + 3];
      }
      x[r] = acc;
    }
#pragma unroll
    for (int r = 0; r < 16; ++r) Ti[blk * 320 + r * 20 + jc] = x[r];
  } else {
    for (int idx = tid - 64; idx < 64 * 128; idx += 448) {
      const int c = idx >> 7, col = idx & 127;
      Qf[c * 132 + col] = Kf[c * 132 + col] * bet[c] * __expf(gc[c]);
    }
  }
  __syncthreads();
  {
    const int m = lane & 15, kq = lane >> 4;
    float* R = (wave < 4) ? Vb : Qf;
    const int cbase = 32 * (wave & 3);
    f32x4 X[4][2];
#pragma unroll
    for (int i = 0; i < 4; ++i) {
      f32x4 Y[2];
#pragma unroll
      for (int nt = 0; nt < 2; ++nt)
#pragma unroll
        for (int j = 0; j < 4; ++j) Y[nt][j] = R[(16 * i + 4 * kq + j) * 132 + cbase + 16 * nt + m];
#pragma unroll
      for (int p = 0; p < i; ++p) {
        f32x4 l4 = *reinterpret_cast<const f32x4*>(Lm + (16 * i + m) * 68 + 16 * p + 4 * kq);
#pragma unroll
        for (int t = 0; t < 4; ++t)
#pragma unroll
          for (int nt = 0; nt < 2; ++nt) Y[nt] = __builtin_amdgcn_mfma_f32_16x16x4f32(-l4[t], X[p][nt][t], Y[nt], 0, 0, 0);
      }
      f32x4 t4 = *reinterpret_cast<const f32x4*>(Ti + i * 320 + m * 20 + 4 * kq);
#pragma unroll
      for (int nt = 0; nt < 2; ++nt) {
        f32x4 zacc = (f32x4){0.f, 0.f, 0.f, 0.f};
#pragma unroll
        for (int t = 0; t < 4; ++t) zacc = __builtin_amdgcn_mfma_f32_16x16x4f32(t4[t], Y[nt][t], zacc, 0, 0, 0);
        X[i][nt] = zacc;
      }
    }
    if (wave < 4) {
      bf16x4* UF = (bf16x4*)(rec + 57344);
#pragma unroll
      for (int i = 0; i < 4; ++i)
#pragma unroll
        for (int nt = 0; nt < 2; ++nt) {
          bf16x4 u4; u4[0] = (short)f2bf(X[i][nt][0]); u4[1] = (short)f2bf(X[i][nt][1]); u4[2] = (short)f2bf(X[i][nt][2]); u4[3] = (short)f2bf(X[i][nt][3]);
          st_wt8(UF + ((2 * wave + nt) * 4 + i) * 64 + lane, u4);
        }
    } else {
#pragma unroll
      for (int i = 0; i < 4; ++i)
#pragma unroll
        for (int nt = 0; nt < 2; ++nt)
#pragma unroll
          for (int j = 0; j < 4; ++j) Qf[(16 * i + 4 * kq + j) * 132 + cbase + 16 * nt + m] = X[i][nt][j];
    }
  }
  __syncthreads();
  emit_frag((bf16x8*)(rec), 4, 4, [&](int row, int col) { return -Qf[row * 132 + col]; });
  asm volatile("s_waitcnt vmcnt(0)" ::: "memory");
  __syncthreads();
  if (tid == 0) __hip_atomic_store((int*)(a.ws + WS_CTL) + item, 1, __ATOMIC_RELAXED, __HIP_MEMORY_SCOPE_AGENT);
}

#define AS3 __attribute__((address_space(3)))
constexpr int SCAN_BUF = 57344;
__device__ __forceinline__ void scan_wait(const int* flags, int c, int nch, int& known) {
  if (known > c) return;
  const int lane = threadIdx.x & 63;
  while (known <= c) {
    const int idx = known + lane;
    int f = 0;
    if (lane < 16) f = (idx < nch) ? __hip_atomic_load(flags + idx, __ATOMIC_RELAXED, __HIP_MEMORY_SCOPE_AGENT) : 1;
    const unsigned long long m = __ballot(f != 0);
    const int cnt = __builtin_ctzll(~m);
    if (cnt == 0) __builtin_amdgcn_s_sleep(8);
    known += (cnt > 16) ? 16 : cnt;
  }
  __builtin_amdgcn_fence(__ATOMIC_ACQUIRE, "agent");
}
__device__ __forceinline__ void scan_dma(const unsigned char* rec, unsigned char* fbuf, unsigned char* ubuf, int t256) {
#pragma unroll
  for (int i = 0; i < 14; ++i)
    __builtin_amdgcn_global_load_lds((const unsigned*)(rec + (i * 256 + t256) * 16), (AS3 unsigned*)(fbuf + (i * 256 + t256) * 16), 16, 0, 0);
#pragma unroll
  for (int i = 0; i < 4; ++i)
    __builtin_amdgcn_global_load_lds((const unsigned*)(rec + 57344 + (i * 256 + t256) * 16), (AS3 unsigned*)(ubuf + (i * 256 + t256) * 16), 16, 0, 0);
}
__device__ __forceinline__ void gdn_scan_item(const Args& a, int sitem, unsigned char* lds) {
  unsigned char* Ub = lds + 2 * SCAN_BUF;
  u16* Ot = (u16*)(lds + 2 * SCAN_BUF + 32768);
  const int tid = fresh_tid(), lane = tid & 63, w = tid >> 6, n = lane & 15, rg = lane >> 4;
  const bool mw = w < 4;
  const bool samp = sitem >= 16;
  int bb, h, nch, rec0, rowbase; size_t orec;
  if (!samp) { bb = sitem >> 2; h = sitem & 3; nch = 64; rec0 = sitem * 64; rowbase = bb * SEQ; orec = O_RECP + (size_t)sitem * 16384; }
  else { int s = sitem - 16; bb = s >> 2; h = s & 3; nch = 1; rec0 = 1024 + s; rowbase = NPR + bb * 8; orec = O_RECS + (size_t)s * 16384; }
  const u16* Z = (const u16*)(a.ws + WS_Z);
  u16* MIX = (u16*)(a.ws + WS_MIX);
  const unsigned char* recb = a.ws + WS_GDN + (size_t)rec0 * GREC;
  __syncthreads();
  if (mw) {
    f32x4 S[8][2];
#pragma unroll
    for (int i = 0; i < 8; ++i) { S[i][0] = (f32x4){0.f, 0.f, 0.f, 0.f}; S[i][1] = (f32x4){0.f, 0.f, 0.f, 0.f}; }
    if (samp) {
      const float* sp = a.in[3] + (size_t)(sitem - 16) * 16384 + (4 * rg) * 128 + 32 * w + n;
#pragma unroll
      for (int i = 0; i < 8; ++i)
#pragma unroll
        for (int nt = 0; nt < 2; ++nt)
#pragma unroll
          for (int j = 0; j < 4; ++j) S[i][nt][j] = sp[(16 * i + j) * 128 + 16 * nt];
    }
    const int* flags = (const int*)(a.ws + WS_CTL) + rec0;
    int known = 0;
    scan_wait(flags, 0, nch, known);
    scan_dma(recb, lds, Ub, tid);
#pragma unroll 1
    for (int ch = 0; ch < nch; ++ch) {
      asm volatile("s_waitcnt vmcnt(0)" ::: "memory");
      __syncthreads();
      const unsigned char* bufp = lds + (ch & 1) * SCAN_BUF;
      const unsigned char* ubp = Ub + (ch & 1) * 16384;
      if (ch + 1 < nch) {
        scan_wait(flags, ch + 1, nch, known);
        scan_dma(recb + (size_t)(ch + 1) * GREC, lds + ((ch + 1) & 1) * SCAN_BUF, Ub + ((ch + 1) & 1) * 16384, tid);
      }
      const float egl = *(const float*)(bufp + 49152 + 1024);
      const bf16x8* WF = (const bf16x8*)bufp; const bf16x8* QGF = (const bf16x8*)(bufp + 16384);
      const bf16x8* KDF = (const bf16x8*)(bufp + 32768); const bf16x8* QKF = (const bf16x8*)(bufp + 49152);
      f32x4 e[4][2], o[4][2];
#pragma unroll
      for (int tt = 0; tt < 4; ++tt)
#pragma unroll
        for (int nt = 0; nt < 2; ++nt) {
          const uint2 u2 = ((const uint2*)ubp)[((2 * w + nt) * 4 + tt) * 64 + lane];
          e[tt][nt] = (f32x4){bflo(u2.x), bfhi(u2.x), bflo(u2.y), bfhi(u2.y)};
          o[tt][nt] = (f32x4){0.f, 0.f, 0.f, 0.f};
        }
#pragma unroll
      for (int ks = 0; ks < 4; ++ks) {
        const bf16x8 Sb0 = pack8(S[2 * ks][0], S[2 * ks + 1][0]);
        const bf16x8 Sb1 = pack8(S[2 * ks][1], S[2 * ks + 1][1]);
#pragma unroll
        for (int tt = 0; tt < 4; ++tt) {
          bf16x8 af = WF[(tt * 4 + ks) * 64 + lane];
          e[tt][0] = __builtin_amdgcn_mfma_f32_16x16x32_bf16(af, Sb0, e[tt][0], 0, 0, 0);
          e[tt][1] = __builtin_amdgcn_mfma_f32_16x16x32_bf16(af, Sb1, e[tt][1], 0, 0, 0);
        }
#pragma unroll
        for (int tc = 0; tc < 4; ++tc) {
          bf16x8 af = QGF[(tc * 4 + ks) * 64 + lane];
          o[tc][0] = __builtin_amdgcn_mfma_f32_16x16x32_bf16(af, Sb0, o[tc][0], 0, 0, 0);
          o[tc][1] = __builtin_amdgcn_mfma_f32_16x16x32_bf16(af, Sb1, o[tc][1], 0, 0, 0);
        }
      }
      bf16x8 eb[2][2];
#pragma unroll
      for (int kt = 0; kt < 2; ++kt)
#pragma unroll
        for (int nt = 0; nt < 2; ++nt) eb[kt][nt] = pack8(e[2 * kt][nt], e[2 * kt + 1][nt]);
#pragma unroll
      for (int tc = 0; tc < 4; ++tc) {
#pragma unroll
        for (int kt = 0; kt < 2; ++kt) {
          if (tc == 0 && kt == 1) continue;
          bf16x8 af = QKF[(tc * 2 + kt) * 64 + lane];
          o[tc][0] = __builtin_amdgcn_mfma_f32_16x16x32_bf16(af, eb[kt][0], o[tc][0], 0, 0, 0);
          o[tc][1] = __builtin_amdgcn_mfma_f32_16x16x32_bf16(af, eb[kt][1], o[tc][1], 0, 0, 0);
        }
      }
      __syncthreads();
#pragma unroll
      for (int tc = 0; tc < 4; ++tc)
#pragma unroll
        for (int nt = 0; nt < 2; ++nt)
#pragma unroll
          for (int j = 0; j < 4; ++j) { const int row = 16 * tc + 4 * rg + j; Ot[row * 128 + 16 * ((2 * w + nt) ^ (row & 7)) + n] = f2bf(o[tc][nt][j]); }
#pragma unroll
      for (int i = 0; i < 8; ++i) {
        f32x4 ac0 = S[i][0] * egl, ac1 = S[i][1] * egl;
#pragma unroll
        for (int kt = 0; kt < 2; ++kt) {
          bf16x8 af = KDF[(i * 2 + kt) * 64 + lane];
          ac0 = __builtin_amdgcn_mfma_f32_16x16x32_bf16(af, eb[kt][0], ac0, 0, 0, 0);
          ac1 = __builtin_amdgcn_mfma_f32_16x16x32_bf16(af, eb[kt][1], ac1, 0, 0, 0);
        }
        S[i][0] = ac0; S[i][1] = ac1;
      }
    }
    __syncthreads();
#pragma unroll
    for (int i = 0; i < 8; ++i)
#pragma unroll
      for (int nt = 0; nt < 2; ++nt)
#pragma unroll
        for (int j = 0; j < 4; ++j) a.out[orec + (16 * i + 4 * rg + j) * 128 + 32 * w + 16 * nt + n] = S[i][nt][j];
  } else {
    const int t = tid - 256, otok = t >> 2, oq = t & 3;
    const bool ovalid = samp ? (otok < 8) : true;
    float nw[32];
#pragma unroll
    for (int i = 0; i < 8; ++i) { f32x4 w4 = *reinterpret_cast<const f32x4*>(a.in[11] + 32 * oq + 4 * i); nw[4 * i] = w4[0]; nw[4 * i + 1] = w4[1]; nw[4 * i + 2] = w4[2]; nw[4 * i + 3] = w4[3]; }
    const size_t zoff = (size_t)(rowbase + (ovalid ? otok : 0)) * 512 + h * 128 + 32 * oq;
    uint4 zr[4];
    { const uint4* zp = reinterpret_cast<const uint4*>(Z + zoff);
#pragma unroll
      for (int i = 0; i < 4; ++i) zr[i] = zp[i]; }
#pragma unroll 1
    for (int ch = 0; ch <= nch; ++ch) {
      if (ch < nch) __syncthreads();
      uint4 ot[4];
      if (ch == nch) __syncthreads();
      if (ch > 0) {
#pragma unroll
        for (int gq = 0; gq < 2; ++gq) {
          const uint4* orp = reinterpret_cast<const uint4*>(Ot + otok * 128 + 16 * ((2 * oq + gq) ^ (otok & 7)));
          ot[2 * gq] = orp[0]; ot[2 * gq + 1] = orp[1];
        }
      }
      if (ch < nch) __syncthreads();
      if (ch > 0) {
        const int orow = rowbase + (ch - 1) * 64 + (ovalid ? otok : 0);
        const unsigned ov[16] = {ot[0].x, ot[0].y, ot[0].z, ot[0].w, ot[1].x, ot[1].y, ot[1].z, ot[1].w,
                                 ot[2].x, ot[2].y, ot[2].z, ot[2].w, ot[3].x, ot[3].y, ot[3].z, ot[3].w};
        const unsigned zz[16] = {zr[0].x, zr[0].y, zr[0].z, zr[0].w, zr[1].x, zr[1].y, zr[1].z, zr[1].w,
                                 zr[2].x, zr[2].y, zr[2].z, zr[2].w, zr[3].x, zr[3].y, zr[3].z, zr[3].w};
        if (ch < nch) {
          const uint4* zp = reinterpret_cast<const uint4*>(Z + zoff + (size_t)ch * 64 * 512);
#pragma unroll
          for (int i = 0; i < 4; ++i) zr[i] = zp[i];
        }
        float ss = 0.f;
#pragma unroll
        for (int q = 0; q < 16; ++q) { float x0 = bflo(ov[q]), x1 = bfhi(ov[q]); ss += x0 * x0 + x1 * x1; }
        ss += __shfl_xor(ss, 1); ss += __shfl_xor(ss, 2);
        const float rstd = rsqrtf(ss * (1.f / 128.f) + EPS);
        unsigned outp[16];
#pragma unroll
        for (int q = 0; q < 16; ++q) {
          float oa = bflo(ov[q]) * rstd * nw[2 * q] * silu_f(bflo(zz[q]));
          float ob = bfhi(ov[q]) * rstd * nw[2 * q + 1] * silu_f(bfhi(zz[q]));
          outp[q] = pack2(oa, ob);
        }
        if (ovalid) {
          uint4* op = reinterpret_cast<uint4*>(MIX + (size_t)orow * DM + h * 128 + 32 * oq);
#pragma unroll
          for (int i = 0; i < 4; ++i) op[i] = make_uint4(outp[4 * i], outp[4 * i + 1], outp[4 * i + 2], outp[4 * i + 3]);
        }
      }
    }
  }
  __syncthreads();
}

struct KVRegs { bf16x8 k[4], v[4]; };
__device__ __forceinline__ void attn_fetch(const Args& a, KVRegs& R, bool samp, int bb, int h, int krow0, int C0, int tid, int br) {
  const u16* KB = (const u16*)(a.ws + WS_KB);
  const u16* VB = (const u16*)(a.ws + WS_VB);
#pragma unroll
  for (int i = 0; i < 4; ++i) {
    const int idx = tid + 512 * i; const int tl = idx >> 3, seg = idx & 7; const int p = C0 + tl;
    bf16x8 kv = (bf16x8){0, 0, 0, 0, 0, 0, 0, 0}, vv = (bf16x8){0, 0, 0, 0, 0, 0, 0, 0};
    if (!samp) {
      kv = *reinterpret_cast<const bf16x8*>(KB + (size_t)(krow0 + p) * 512 + h * 64 + seg * 8);
      vv = *reinterpret_cast<const bf16x8*>(VB + (size_t)(krow0 + p) * 512 + h * 64 + seg * 8);
    } else if ((br == 0 && (tl & 15) >= 8) || (br == 2 && p < 1920)) {
    } else if (p < 2048) {
      const float* kp = a.in[4] + ((size_t)(bb * 2048 + p) * 8 + h) * 64 + seg * 8;
      const float* vp = a.in[5] + ((size_t)(bb * 2048 + p) * 8 + h) * 64 + seg * 8;
      f32x4 k0 = *reinterpret_cast<const f32x4*>(kp), k1 = *reinterpret_cast<const f32x4*>(kp + 4);
      f32x4 v0 = *reinterpret_cast<const f32x4*>(vp), v1 = *reinterpret_cast<const f32x4*>(vp + 4);
      kv = pack8(k0, k1); vv = pack8(v0, v1);
    } else if (p < 2056) {
      kv = *reinterpret_cast<const bf16x8*>(KB + (size_t)(NPR + bb * 8 + p - 2048) * 512 + h * 64 + seg * 8);
      vv = *reinterpret_cast<const bf16x8*>(VB + (size_t)(NPR + bb * 8 + p - 2048) * 512 + h * 64 + seg * 8);
    }
    R.k[i] = kv; R.v[i] = vv;
  }
}

__device__ __forceinline__ void attn_item(const Args& a, int item, unsigned char* lds) {
  float* St = (float*)lds;
  u16* Kc = (u16*)(lds + 69632);
  u16* Vr = (u16*)(lds + 69632 + 36864);
  const int tid = fresh_tid(), lane = tid & 63, w = tid >> 6, n = lane & 15, rg = lane >> 4;
  const bool samp = item >= 512;
  int bb, h, T0, nvalid, qrow0, krow0;
  if (!samp) { bb = item >> 7; h = (item >> 4) & 7; int sp = item & 15; T0 = sp * 256; nvalid = 256; qrow0 = bb * SEQ + T0; krow0 = bb * SEQ; }
  else { int s = item - 512; bb = s >> 3; h = s & 7; T0 = 2048; nvalid = 8; qrow0 = NPR + bb * 8; krow0 = 0; }
  const float slope = exp2f(-(float)(h + 1));
  const u16* QB = (const u16*)(a.ws + WS_QB);
  __syncthreads();
  for (int idx = tid; idx < 256 * 68; idx += NTHR) { int c = idx % 68; St[idx] = (c == 64) ? -1e30f : 0.f; }
  __syncthreads();
#pragma unroll 1
  for (int br = 0; br < 3; ++br) {
    const int d = (br == 0) ? 16 : (br == 1) ? 4 : 1;
    const int nq = 16 / d;
    const int nch = (br == 0) ? 9 : (br == 1) ? 3 : 2;
    const int nk = 256 / d;
    const int dsh = (br == 0) ? 4 : (br == 1) ? 2 : 0;
    int ur[2], uqt[2], utq[2]; bool uact[2];
    bf16x8 Qf[2][2]; f32x4 acc[2][4]; float mrun[2], lrun[2];
#pragma unroll
    for (int uu = 0; uu < 2; ++uu) {
      const int ui = 2 * w + uu;
      ur[uu] = ui / nq; uqt[uu] = ui % nq;
      utq[uu] = d * (16 * uqt[uu] + n) + ur[uu];
      uact[uu] = (d * 16 * uqt[uu] + ur[uu]) < nvalid;
      const bool qv = utq[uu] < nvalid;
#pragma unroll
      for (int s2 = 0; s2 < 2; ++s2) {
        bf16x8 q = (bf16x8){0, 0, 0, 0, 0, 0, 0, 0};
        if (qv) q = *reinterpret_cast<const bf16x8*>(QB + (size_t)(qrow0 + utq[uu]) * 512 + h * 64 + 32 * s2 + 8 * rg);
        Qf[uu][s2] = q;
      }
#pragma unroll
      for (int dt = 0; dt < 4; ++dt) acc[uu][dt] = *reinterpret_cast<const f32x4*>(St + utq[uu] * 68 + 16 * dt + 4 * rg);
      mrun[uu] = St[utq[uu] * 68 + 64];
      lrun[uu] = (rg == 0) ? St[utq[uu] * 68 + 65] : 0.f;
    }
    int ck = (nch - 1) - (T0 >> 8); if (ck < 0) ck = 0;
    KVRegs R;
    attn_fetch(a, R, samp, bb, h, krow0, T0 + 256 * (ck - (nch - 1)), tid, br);
#pragma unroll 1
    for (; ck < nch; ++ck) {
      __syncthreads();
#pragma unroll
      for (int i = 0; i < 4; ++i) {
        const int idx = tid + 512 * i; const int tl = idx >> 3, seg = idx & 7;
        const int kidx = (tl & (d - 1)) * nk + (tl >> dsh);
        *reinterpret_cast<bf16x8*>(Kc + kidx * 72 + seg * 8) = R.k[i];
        *reinterpret_cast<bf16x8*>(Vr + kidx * 72 + seg * 8) = R.v[i];
      }
      __syncthreads();
      if (ck + 1 < nch) attn_fetch(a, R, samp, bb, h, krow0, T0 + 256 * (ck + 1 - (nch - 1)), tid, br);
#pragma unroll
      for (int uu = 0; uu < 2; ++uu) {
        if (!uact[uu]) continue;
        const int r = ur[uu], qt = uqt[uu];
        for (int kt = 0; kt < nq; ++kt) {
          const int Dl = qt - kt - nq * (ck - (nch - 1));
          if (Dl < 0 || Dl > 8) continue;
          const int kbase = r * nk + 16 * kt;
          f32x4 s4 = (f32x4){0.f, 0.f, 0.f, 0.f};
#pragma unroll
          for (int s2 = 0; s2 < 2; ++s2) {
            bf16x8 ka = *reinterpret_cast<const bf16x8*>(Kc + (kbase + n) * 72 + 32 * s2 + 8 * rg);
            s4 = __builtin_amdgcn_mfma_f32_16x16x32_bf16(ka, Qf[uu][s2], s4, 0, 0, 0);
          }
          float sc[4]; bool vl[4]; float mloc = -1e30f;
#pragma unroll
          for (int jj = 0; jj < 4; ++jj) {
            const int j = 16 * Dl + n - (4 * rg + jj);
            vl[jj] = (j >= 0) && (j <= 128);
            sc[jj] = vl[jj] ? (s4[jj] * 0.125f - slope * (float)(j * d)) : -1e30f;
            mloc = fmaxf(mloc, sc[jj]);
          }
          mloc = fmaxf(mloc, __shfl_xor(mloc, 16));
          mloc = fmaxf(mloc, __shfl_xor(mloc, 32));
          const float mnew = fmaxf(mrun[uu], mloc);
          const float alpha = __expf(mrun[uu] - mnew);
          float p4[4]; float ps = 0.f;
#pragma unroll
          for (int jj = 0; jj < 4; ++jj) { p4[jj] = vl[jj] ? __expf(sc[jj] - mnew) : 0.f; ps += p4[jj]; }
          lrun[uu] = lrun[uu] * alpha + ps;
          mrun[uu] = mnew;
          bf16x4 pb;
          pb[0] = (short)f2bf(p4[0]); pb[1] = (short)f2bf(p4[1]); pb[2] = (short)f2bf(p4[2]); pb[3] = (short)f2bf(p4[3]);
#pragma unroll
          for (int dt = 0; dt < 4; ++dt) {
            bf16x4 va = __builtin_amdgcn_ds_read_tr16_b64_v4i16((AS3 bf16x4*)(Vr + (kbase + 4 * rg + (n >> 2)) * 72 + 16 * dt + 4 * (n & 3)));
            f32x4 t = acc[uu][dt] * alpha;
            acc[uu][dt] = __builtin_amdgcn_mfma_f32_16x16x16bf16_1k(va, pb, t, 0, 0, 0);
          }
        }
      }
    }
#pragma unroll
    for (int uu = 0; uu < 2; ++uu) {
      float lt = lrun[uu];
      lt += __shfl_xor(lt, 16); lt += __shfl_xor(lt, 32);
#pragma unroll
      for (int dt = 0; dt < 4; ++dt) *reinterpret_cast<f32x4*>(St + utq[uu] * 68 + 16 * dt + 4 * rg) = acc[uu][dt];
      if (rg == 0) { St[utq[uu] * 68 + 64] = mrun[uu]; St[utq[uu] * 68 + 65] = lt; }
    }
    __syncthreads();
  }
  {
    const int tq = tid >> 1, half = tid & 1;
    float v[32]; float ss = 0.f;
    const float linv = 1.f / St[tq * 68 + 65];
#pragma unroll
    for (int q = 0; q < 8; ++q) {
      f32x4 t4 = *reinterpret_cast<const f32x4*>(St + tq * 68 + 32 * half + 4 * q);
#pragma unroll
      for (int e = 0; e < 4; ++e) { float x = t4[e] * linv; v[4 * q + e] = x; ss += x * x; }
    }
    ss += __shfl_xor(ss, 1);
    const float rstd = rsqrtf(ss * (1.f / 64.f) + EPS);
    if (tq < nvalid) {
      u16* MIX = (u16*)(a.ws + WS_MIX);
      unsigned outp[16];
#pragma unroll
      for (int q = 0; q < 16; ++q) {
        float oa = v[2 * q] * rstd * a.in[12][32 * half + 2 * q];
        float ob = v[2 * q + 1] * rstd * a.in[12][32 * half + 2 * q + 1];
        outp[q] = pack2(oa, ob);
      }
      uint4* op = reinterpret_cast<uint4*>(MIX + (size_t)(qrow0 + tq) * DM + 512 + h * 64 + 32 * half);
#pragma unroll
      for (int q = 0; q < 4; ++q) op[q] = make_uint4(outp[4 * q], outp[4 * q + 1], outp[4 * q + 2], outp[4 * q + 3]);
    }
  }
  __syncthreads();
}

#define XB_TMO      128
#define XB_XCNT(j)  (256  + 64 * (j))
#define XB_XSUB(j)  (1280 + 64 * (j))
#define XB_XGEN(j)  (2304 + 64 * (j))
#define XB_TOP      3328
#define XB_TOPGEN   3392
#define XCD_BAR_WORDS 3456
#define XB_SPIN_CAP (1u << 20)
__device__ __forceinline__ unsigned xb_ld(unsigned* p)              { return __hip_atomic_load(p, __ATOMIC_RELAXED, __HIP_MEMORY_SCOPE_AGENT); }
__device__ __forceinline__ unsigned xb_add(unsigned* p, unsigned v) { return __hip_atomic_fetch_add(p, v, __ATOMIC_RELAXED, __HIP_MEMORY_SCOPE_AGENT); }
__device__ __forceinline__ unsigned xb_xcc_id() { return (unsigned)__builtin_amdgcn_s_getreg((3 << 11) | 20) & 0xFu; }
#define XB_SPIN(cond, bar) do { unsigned _sp = 0; while (cond) { __builtin_amdgcn_s_sleep(1); \
    if ((++_sp & 255u) == 0u) { if (xb_ld(&(bar)[XB_TMO])) break; if (_sp > XB_SPIN_CAP) { atomicAdd(&(bar)[XB_TMO], 1u); break; } } } } while (0)
struct XcdBarrier { unsigned* bar; unsigned x, nloc, nx; };
__device__ __forceinline__ void xcd_barrier_complete(unsigned* bar, unsigned x, unsigned& nloc, unsigned& nx) {
  const unsigned G = gridDim.x;
  unsigned sum, cnt, mine, sp = 0u;
  for (;;) {
    sum = 0u; cnt = 0u; mine = 0u;
#pragma unroll
    for (unsigned j = 0; j < 16; ++j) { const unsigned c = xb_ld(&bar[XB_XCNT(j)]); sum += c; cnt += (c > 0u) ? 1u : 0u; mine = (j == x) ? c : mine; }
    if (sum == G) break;
    __builtin_amdgcn_s_sleep(1);
    if ((++sp & 255u) == 0u) { if (xb_ld(&bar[XB_TMO])) break; if (sp > XB_SPIN_CAP) { atomicAdd(&bar[XB_TMO], 1u); break; } }
  }
  nloc = mine > 0u ? mine : 1u; nx = cnt > 0u ? cnt : 1u;
}
__device__ __forceinline__ void xcd_barrier(XcdBarrier& b) {
  asm volatile("s_waitcnt vmcnt(0)" ::: "memory");
  __syncthreads();
  if (threadIdx.x == 0) {
    unsigned* bar = b.bar;
    __builtin_amdgcn_s_waitcnt(0);
    unsigned nloc = b.nloc, nx = b.nx;
    if (nloc == 0u) { xcd_barrier_complete(bar, b.x, nloc, nx); }
    b.nloc = __builtin_amdgcn_readfirstlane(nloc); b.nx = __builtin_amdgcn_readfirstlane(nx);
    const unsigned old = xb_add(&bar[XB_XSUB(b.x)], 1u);
    const unsigned gen = old / nloc;
    if (old + 1u == (gen + 1u) * nloc) {
      __builtin_amdgcn_fence(__ATOMIC_RELEASE, "agent");
      asm volatile("s_waitcnt vmcnt(0)" ::: "memory");
      const unsigned og = xb_add(&bar[XB_TOP], 1u);
      const unsigned tg = og / nx;
      if (og + 1u == (tg + 1u) * nx) xb_add(&bar[XB_TOPGEN], 1u);
      else XB_SPIN(xb_ld(&bar[XB_TOPGEN]) == tg, bar);
      __builtin_amdgcn_fence(__ATOMIC_ACQUIRE, "agent");
      xb_add(&bar[XB_XGEN(b.x)], 1u);
      asm volatile("s_waitcnt vmcnt(0)" ::: "memory");
    } else {
      XB_SPIN(xb_ld(&bar[XB_XGEN(b.x)]) == gen, bar);
      __builtin_amdgcn_fence(__ATOMIC_ACQUIRE, "agent");
      asm volatile("s_waitcnt vmcnt(0)" ::: "memory");
    }
  }
  __syncthreads();
}

__device__ __forceinline__ bool tile_of(int round, int C, int& pm, int& pn, int& o) {
  const int b = blockIdx.x;
  o = (gridDim.x == 256) ? ((round * 8 + (b & 7)) * 32 + (b >> 3)) : (round * (int)gridDim.x + b);
  if (o >= 65 * C) return false;
  const int nfull = C >> 2;
  if (o < nfull * 260) { const int cg = o / 260, rem = o - cg * 260; pm = rem >> 2; pn = 4 * cg + (rem & 3); }
  else { const int rem = o - nfull * 260, w = C & 3; pm = rem / w; pn = 4 * nfull + (rem - pm * w); }
  return true;
}

__global__ void __launch_bounds__(NTHR) fwd_kernel(Args a) {
  extern __shared__ __attribute__((aligned(16))) unsigned char lds[];
  const int lo = a.ph_lo, hi = a.ph_hi;
  XcdBarrier xb; xb.bar = (unsigned*)(a.ws + WS_BAR); xb.x = xb_xcc_id(); xb.nloc = 0u; xb.nx = 0u;
  if (threadIdx.x == 0 && hi - lo > 1) (void)xb_add(&xb.bar[XB_XCNT(xb.x)], 1u);
  if (lo < 0) cg::this_grid().sync();
#ifndef PHM
#define PHM 0x1ff
#endif
#define IN(k) ((((PHM) >> (k)) & 1) && lo <= (k) && (k) < hi)
#ifndef REPM
#define REPM 0
#endif
#define NREP(k) ((((REPM) >> (k)) & 1) ? 2 : 1)
#define SEAM(k) do { if (IN(k) && IN((k) + 1)) { xcd_barrier(xb); } } while (0)
  if (IN(0)) for (int rep_ = 0; rep_ < NREP(0); ++rep_) { phase0(a, lds); }
  SEAM(0);
  if (IN(1)) for (int rep_ = 0; rep_ < NREP(1); ++rep_) {
    const u16* H = (const u16*)(a.ws + WS_H); const u16* W = (const u16*)(a.ws + WS_WIN);
    float* outp = a.out;
    int oslot = 0;
    for (int rnd = 0;; ++rnd) {
      int pm, pn; if (!tile_of(rnd, 15, pm, pn, oslot)) break;
      const int brow = pm * 256, bcol = pn * 256;
      if (pn < 6) {
        u16* dst = (u16*)(a.ws + WS_QKVA);
        gemm_tile(lds, H, W, DM, DM, brow, bcol, [=](f32x4 c0, f32x4 c1, int row0, int col0) {
          const unsigned o = (unsigned)row0 * 1536u + (unsigned)col0;
#pragma unroll
          for (int j = 0; j < 4; ++j) { dst[o + j * 1536] = f2bf(c0[j]); dst[o + j * 1536 + 16] = f2bf(c1[j]); }
          if (row0 < NPR) {
            if ((row0 & 4095) == 4092) {
              const unsigned oo = (unsigned)O_CONVP + (unsigned)((row0 >> 12) * 3) * 1536u + (unsigned)col0;
#pragma unroll
              for (int j = 1; j < 4; ++j) { outp[oo + (j - 1) * 1536] = c0[j]; outp[oo + (j - 1) * 1536 + 16] = c1[j]; }
            }
          } else if (((row0 - NPR) & 7) == 4) {
            const unsigned oo = (unsigned)O_CONVS + (unsigned)(((row0 - NPR) >> 3) * 3) * 1536u + (unsigned)col0;
#pragma unroll
            for (int j = 1; j < 4; ++j) { outp[oo + (j - 1) * 1536] = c0[j]; outp[oo + (j - 1) * 1536 + 16] = c1[j]; }
          }
        });
      } else if (pn < 10) {
        u16* dst = (u16*)(a.ws + (pn < 8 ? WS_Z : WS_QB));
        const int cbase = (pn < 8) ? 1536 : 2048;
        gemm_tile(lds, H, W, DM, DM, brow, bcol, [=](f32x4 c0, f32x4 c1, int row0, int col0) {
          const unsigned o = (unsigned)row0 * 512u + (unsigned)(col0 - cbase);
#pragma unroll
          for (int j = 0; j < 4; ++j) { dst[o + j * 512] = f2bf(c0[j]); dst[o + j * 512 + 16] = f2bf(c1[j]); }
        });
      } else if (pn < 14) {
        const bool isk = pn < 12;
        u16* dst = (u16*)(a.ws + (isk ? WS_KB : WS_VB));
        const int cbase = isk ? 2560 : 3072;
        const unsigned offp = (unsigned)(isk ? O_WKP : O_WVP), offs = (unsigned)(isk ? O_WKS : O_WVS);
        gemm_tile(lds, H, W, DM, DM, brow, bcol, [=](f32x4 c0, f32x4 c1, int row0, int col0) {
          const unsigned cl = (unsigned)(col0 - cbase);
          const unsigned o = (unsigned)row0 * 512u + cl;
#pragma unroll
          for (int j = 0; j < 4; ++j) { dst[o + j * 512] = f2bf(c0[j]); dst[o + j * 512 + 16] = f2bf(c1[j]); }
          if (row0 < NPR) {
            const int tt = row0 & 4095;
            if (tt >= 2048) {
              const unsigned oo = offp + ((unsigned)(row0 >> 12) * 2048u + (unsigned)(tt - 2048)) * 512u + cl;
#pragma unroll
              for (int j = 0; j < 4; ++j) { outp[oo + j * 512] = c0[j]; outp[oo + j * 512 + 16] = c1[j]; }
            }
          } else {
            const int r2 = row0 - NPR;
            const unsigned oo = offs + ((unsigned)(r2 >> 3) * 2048u + 2040u + (unsigned)(r2 & 7)) * 512u + cl;
#pragma unroll
            for (int j = 0; j < 4; ++j) { outp[oo + j * 512] = c0[j]; outp[oo + j * 512 + 16] = c1[j]; }
          }
        });
      } else {
        float* BETA = (float*)(a.ws + WS_BETA); float* Gd = (float*)(a.ws + WS_G);
        const float* alog = a.in[9]; const float* dtb = a.in[10];
        gemm_tile(lds, H, W, DM, DM, brow, bcol, [=](f32x4 c0, f32x4 c1, int row0, int col0) {
          const int cl = col0 - 3584;
          if (cl < 8) {
            const int hh = cl & 3;
#pragma unroll
            for (int j = 0; j < 4; ++j) {
              const int row = row0 + j;
              if (cl < 4) BETA[row * 4 + hh] = 1.f / (1.f + expf(-c0[j]));
              else { float xx = c0[j] + dtb[hh]; float sp = (xx > 20.f) ? xx : log1pf(expf(xx)); Gd[row * 4 + hh] = -expf(alog[hh]) * sp; }
            }
          }
        });
      }
    }
    if (gridDim.x == 256 && oslot >= 975 && oslot < 1024) copy_range(a, 0, 588, oslot - 975, 49, fresh_tid());
  }
  do { if (IN(1) && IN(3)) { xcd_barrier(xb); } } while (0);
  if (IN(3)) {
    int* qctr = (int*)(a.ws + WS_CTL + 6144);
    int* qslot = (int*)(lds + LDS_BYTES - 16);
    const bool ded = (gridDim.x == 256);
    if (ded && blockIdx.x < 16) gdn_scan_item(a, blockIdx.x, lds);
    else for (;;) {
      __syncthreads();
      if (threadIdx.x == 0) *qslot = __hip_atomic_fetch_add(qctr, 1, __ATOMIC_RELAXED, __HIP_MEMORY_SCOPE_AGENT);
      __syncthreads();
      const int q = *qslot;
      if (ded && q >= 2048) {
        const int ci = q - 2048;
        if (ci < 357) {
          const int j0 = 1224 + ci * 8, j1 = (j0 + 8 < 4080) ? j0 + 8 : 4080;
          copy_range(a, j0, j1, 0, 1, fresh_tid());
          continue;
        }
        const int ti = ci - 357;
        if (ti >= (J_T3 - J_T0) / 2) break;
        p0_transpose(a, J_T0 + 2 * ti, lds);
        p0_transpose(a, J_T0 + 2 * ti + 1, lds);
        continue;
      }
      if (q >= 2048 + (ded ? 0 : 16)) break;
      if (q < 1152) {
        const int item = (q < 1024) ? ((q & 15) * 64 + (q >> 4)) : q;
        gdn_prep_item(a, item, lds);
      } else if (q < 1664) attn_item(a, 511 - (q - 1152), lds);
      else if (q < 1920) attn_item(a, 512 + (q - 1664), lds);
      else if (q < 2048) gdn_scan_item(a, 16 + (q - 1920), lds);
      else gdn_scan_item(a, q - 2048, lds);
    }
  }
  SEAM(3);
  if (IN(4)) for (int rep_ = 0; rep_ < NREP(4); ++rep_) {
    const u16* MIX = (const u16*)(a.ws + WS_MIX); const u16* W = (const u16*)(a.ws + WS_WOUT);
    float* X1 = (float*)(a.ws + WS_X1);
    const float* xp = a.in[0]; const float* xs = a.in[1];
    const bool splitk = (gridDim.x == 256);
    int oslot = 0;
    for (int rnd = 0;; ++rnd) {
      int pm, pn; if (!tile_of(rnd, 4, pm, pn, oslot)) break;
      if (splitk && pm == 64) break;
      gemm_tile(lds, MIX, W, DM, DM, pm * 256, pn * 256, [=](f32x4 c0, f32x4 c1, int row0, int col0) {
#pragma unroll
        for (int j = 0; j < 4; ++j) {
          const unsigned o = (unsigned)(row0 + j) * 1024u + (unsigned)col0;
          const float* xb_ = (row0 < NPR) ? xp : (xs - (size_t)NPR * 1024);
          X1[o] = xb_[o] + c0[j];
          X1[o + 16] = xb_[o + 16] + c1[j];
        }
      });
    }
    if (splitk) {
      if (blockIdx.x < 16) {
        const int pn = blockIdx.x & 3, ks = blockIdx.x >> 2;
        float* PART = (float*)(a.ws + WS_PART4) + (size_t)ks * 256 * 1024;
        gemm_tile(lds, MIX + ks * 256, W + ks * 256, 256, DM, 64 * 256, pn * 256, [=](f32x4 c0, f32x4 c1, int row0, int col0) {
#pragma unroll
          for (int j = 0; j < 4; ++j) {
            const size_t o = (size_t)(row0 + j - NPR) * DM + col0;
            PART[o] = c0[j]; PART[o + 16] = c1[j];
          }
        });
      }
    } else { const int ctid = fresh_tid(); for (int jb = blockIdx.x; jb < 2300; jb += gridDim.x) copy_job(a, jb, ctid); }
  }
  SEAM(4);
  if (IN(5)) for (int rep_ = 0; rep_ < NREP(5); ++rep_) {
    const int wave = fresh_tid() >> 6;
    for (int job = blockIdx.x; job < 1040; job += gridDim.x) {
#pragma unroll
      for (int rr = 0; rr < 2; ++rr) {
        int row = job * 16 + wave * 2 + rr;
        float* x1r = (float*)(a.ws + WS_X1) + (size_t)row * DM;
        if (gridDim.x == 256 && row >= NPR) {
          const int ln = fresh_tid() & 63;
          const float* xr = a.in[1] + (size_t)(row - NPR) * DM;
          const float* pp = (const float*)(a.ws + WS_PART4) + (size_t)(row - NPR) * DM;
#pragma unroll
          for (int i = 0; i < 4; ++i) {
            f32x4 v = *reinterpret_cast<const f32x4*>(xr + (i * 64 + ln) * 4);
#pragma unroll
            for (int ks = 0; ks < 4; ++ks) v += *reinterpret_cast<const f32x4*>(pp + (size_t)ks * 256 * 1024 + (i * 64 + ln) * 4);
            *reinterpret_cast<f32x4*>(x1r + (i * 64 + ln) * 4) = v;
          }
        }
        rms_row_bf16<1>(a, x1r, a.in[14], (u16*)(a.ws + WS_H) + (size_t)row * DM, row);
      }
    }
  }
  SEAM(5);
  if (IN(6)) for (int rep_ = 0; rep_ < NREP(6); ++rep_) {
    const u16* H = (const u16*)(a.ws + WS_H); const u16* W = (const u16*)(a.ws + WS_WGU);
    u16* ACT = (u16*)(a.ws + WS_ACT);
    int oslot = 0;
    for (int rnd = 0;; ++rnd) {
      int pm, pn; if (!tile_of(rnd, 22, pm, pn, oslot)) break;
      const int bcol = pn * 256;
      gemm_tile(lds, H, W, DM, DM, pm * 256, bcol, [=](f32x4 c0, f32x4 c1, int row0, int col0) {
        const int cl = col0 - bcol; const int f = pn * 128 + (cl >> 7) * 64 + ((cl >> 5) & 3) * 16 + (cl & 15);
        const unsigned o = (unsigned)row0 * 2816u + (unsigned)f;
#pragma unroll
        for (int j = 0; j < 4; ++j) ACT[o + j * 2816] = f2bf(silu_f(c0[j]) * c1[j]);
      });
    }
    if (gridDim.x == 256 && oslot >= 1430 && oslot < 1536) copy_range(a, 588, 1224, oslot - 1430, 106, fresh_tid());
  }
  SEAM(6);
  if (IN(7)) for (int rep_ = 0; rep_ < NREP(7); ++rep_) {
    const u16* ACT = (const u16*)(a.ws + WS_ACT); const u16* W = (const u16*)(a.ws + WS_WD);
    const float* X1 = (const float*)(a.ws + WS_X1);
    u16* X2B = (u16*)(a.ws + WS_H);
    const bool splitk = (gridDim.x == 256);
    int oslot = 0;
    for (int rnd = 0;; ++rnd) {
      int pm, pn; if (!tile_of(rnd, 4, pm, pn, oslot)) break;
      if (splitk && pm == 64) break;
      gemm_tile(lds, ACT, W, DFF, DFF, pm * 256, pn * 256, [=](f32x4 c0, f32x4 c1, int row0, int col0) {
#pragma unroll
        for (int j = 0; j < 4; ++j) {
          const unsigned o = (unsigned)(row0 + j) * 1024u + (unsigned)col0;
          X2B[o] = f2bf(X1[o] + c0[j]);
          X2B[o + 16] = f2bf(X1[o + 16] + c1[j]);
        }
      });
    }
    if (splitk) {
      if (blockIdx.x < 44) {
        const int pn = blockIdx.x & 3, ks = blockIdx.x >> 2;
        float* PART = (float*)(a.ws + WS_PART7) + (size_t)ks * 256 * 1024;
        gemm_tile(lds, ACT + ks * 256, W + ks * 256, 256, DFF, 64 * 256, pn * 256, [=](f32x4 c0, f32x4 c1, int row0, int col0) {
#pragma unroll
          for (int j = 0; j < 4; ++j) {
            const size_t o = (size_t)(row0 + j - NPR) * DM + col0;
            PART[o] = c0[j]; PART[o + 16] = c1[j];
          }
        });
      }
    } else { const int ctid = fresh_tid(); for (int jb = 2300 + blockIdx.x; jb < 4080; jb += gridDim.x) copy_job(a, jb, ctid); }
  }
  SEAM(7);
  if (IN(8)) for (int rep_ = 0; rep_ < NREP(8); ++rep_) {
    const int tid = fresh_tid(), lane = tid & 63, wave = tid >> 6;
    for (int job = blockIdx.x; job < 1040; job += gridDim.x) {
      float* yr0 = a.out + (size_t)(job * 16 + wave * 2) * DM;
      f32x4 x[2][4]; float ss[2] = {0.f, 0.f};
#pragma unroll
      for (int rr = 0; rr < 2; ++rr) {
        const int row = job * 16 + wave * 2 + rr;
        if (gridDim.x == 256 && row >= NPR) {
          const float* x1r = (const float*)(a.ws + WS_X1) + (size_t)row * DM;
          const float* pp = (const float*)(a.ws + WS_PART7) + (size_t)(row - NPR) * DM;
#pragma unroll
          for (int i = 0; i < 4; ++i) {
            f32x4 v = *reinterpret_cast<const f32x4*>(x1r + (i * 64 + lane) * 4);
#pragma unroll
            for (int ks = 0; ks < 11; ++ks) v += *reinterpret_cast<const f32x4*>(pp + (size_t)ks * 256 * 1024 + (i * 64 + lane) * 4);
            x[rr][i] = v;
          }
        } else {
          const u16* xb = (const u16*)(a.ws + WS_H) + (size_t)row * DM;
#pragma unroll
          for (int i = 0; i < 4; ++i) {
            const uint2 u = *reinterpret_cast<const uint2*>(xb + (i * 64 + lane) * 4);
            x[rr][i] = (f32x4){bflo(u.x), bfhi(u.x), bflo(u.y), bfhi(u.y)};
          }
        }
      }
#pragma unroll
      for (int rr = 0; rr < 2; ++rr) {
#pragma unroll
        for (int i = 0; i < 4; ++i) ss[rr] += x[rr][i][0] * x[rr][i][0] + x[rr][i][1] * x[rr][i][1] + x[rr][i][2] * x[rr][i][2] + x[rr][i][3] * x[rr][i][3];
        ss[rr] = wave_sum(ss[rr]);
      }
#pragma unroll
      for (int rr = 0; rr < 2; ++rr) {
        const float rstd = rsqrtf(ss[rr] * (1.f / 1024.f) + EPS);
#pragma unroll
        for (int i = 0; i < 4; ++i) {
          f32x4 wv = *reinterpret_cast<const f32x4*>(a.in[18] + (i * 64 + lane) * 4);
          f32x4 y;
          y[0] = x[rr][i][0] * rstd * wv[0]; y[1] = x[rr][i][1] * rstd * wv[1]; y[2] = x[rr][i][2] * rstd * wv[2]; y[3] = x[rr][i][3] * rstd * wv[3];
          *reinterpret_cast<f32x4*>(yr0 + rr * DM + (i * 64 + lane) * 4) = y;
        }
      }
    }
  }
#undef IN
#undef SEAM
}

extern "C" void kernel_launch(void* const* d_in, const int* in_sizes, int n_in, void* d_out, int out_size,
                              void* d_ws, size_t ws_size, hipStream_t stream) {
  static int grid = 0;
  if (grid == 0) {
    if (n_in != 19 || (size_t)out_size != O_END || ws_size < WS_END) {
      fprintf(stderr, "kernel_launch: unexpected shapes n_in %d out %d ws %zu (need %zu)\n", n_in, out_size, ws_size, (size_t)WS_END);
      grid = -1; return;
    }
    int dev = 0, cus = 0, per_cu = 0;
    hipGetDevice(&dev);
    hipDeviceGetAttribute(&cus, hipDeviceAttributeMultiprocessorCount, dev);
    if (hipFuncSetAttribute((const void*)fwd_kernel, hipFuncAttributeMaxDynamicSharedMemorySize, LDS_BYTES) != hipSuccess) {
      fprintf(stderr, "kernel_launch: hipFuncSetAttribute failed\n"); grid = -1; return;
    }
    hipOccupancyMaxActiveBlocksPerMultiprocessor(&per_cu, (const void*)fwd_kernel, NTHR, LDS_BYTES);
    if (per_cu < 1) per_cu = 1;
    grid = cus * per_cu;
    (void)hipGetLastError();
  }
  if (grid < 0) return;
  if (hipMemsetAsync((char*)d_ws + WS_CTL, 0, 32768, stream) != hipSuccess) { fprintf(stderr, "kernel_launch: memset of the ready flags failed\n"); return; }
  Args a{};
  for (int i = 0; i < 19; ++i) a.in[i] = (const float*)d_in[i];
  a.out = (float*)d_out; a.ws = (unsigned char*)d_ws;
#if ONE_LAUNCH
  a.ph_lo = 0; a.ph_hi = 9;
  void* args[] = {&a};
  hipError_t e = hipLaunchCooperativeKernel((const void*)fwd_kernel, dim3(grid), dim3(NTHR), args, LDS_BYTES, stream);
  if (e != hipSuccess) fprintf(stderr, "cooperative launch failed: %s (grid %d)\n", hipGetErrorString(e), grid);
#else
  for (int p = 0; p < 9; ++p) {
    if (p == 2) continue;
    a.ph_lo = p; a.ph_hi = p + 1;
    hipLaunchKernelGGL(fwd_kernel, dim3(grid), dim3(NTHR), LDS_BYTES, stream, a);
  }
#endif
}
```

```cpp
#include <hip/hip_runtime.h>
#include <hip/hip_cooperative_groups.h>
#include <cstdio>
namespace cg = cooperative_groups;

#ifndef ONE_LAUNCH
#define ONE_LAUNCH 1
#endif

typedef unsigned short u16;
typedef __attribute__((ext_vector_type(8))) short bf16x8;
typedef __attribute__((ext_vector_type(4))) short bf16x4;
typedef __attribute__((ext_vector_type(4))) float f32x4;
typedef __attribute__((ext_vector_type(2))) float f32x2;

constexpr int DM = 1024, NPR = 16384, NSM = 256, NT = 16640, SEQ = 4096;
constexpr int CONVD = 1536, INC = 3592, NPROJ = 3584, DFF = 2816, NGU = 5632;
constexpr float EPS = 1e-6f;
constexpr size_t O_Y = 0;
constexpr size_t O_CONVP = (size_t)NT * DM;
constexpr size_t O_RECP = O_CONVP + 4 * 3 * 1536;
constexpr size_t O_WKP = O_RECP + 4 * 4 * 128 * 128;
constexpr size_t O_WVP = O_WKP + (size_t)4 * 2048 * 512;
constexpr size_t O_CONVS = O_WVP + (size_t)4 * 2048 * 512;
constexpr size_t O_RECS = O_CONVS + 32 * 3 * 1536;
constexpr size_t O_WKS = O_RECS + (size_t)32 * 4 * 128 * 128;
constexpr size_t O_WVS = O_WKS + (size_t)32 * 2048 * 512;
constexpr size_t O_END = O_WVS + (size_t)32 * 2048 * 512;
constexpr size_t WS_CTL = 0;
constexpr size_t WS_BAR = 8192;
constexpr size_t WS_WIN = 32768;
constexpr int NPROJP = 3840;
constexpr size_t WS_WOUT = WS_WIN + (size_t)NPROJP * DM * 2;
constexpr size_t WS_WGU = WS_WOUT + (size_t)DM * DM * 2;
constexpr size_t WS_WD = WS_WGU + (size_t)NGU * DM * 2;
constexpr size_t WS_H = WS_WD + (size_t)DM * DFF * 2;
constexpr size_t WS_QKVA = WS_H + (size_t)NT * DM * 2;
constexpr size_t WS_Z = WS_QKVA + (size_t)NT * CONVD * 2;
constexpr size_t WS_QB = WS_Z + (size_t)NT * 512 * 2;
constexpr size_t WS_KB = WS_QB + (size_t)NT * 512 * 2;
constexpr size_t WS_VB = WS_KB + (size_t)NT * 512 * 2;
constexpr size_t WS_BETA = WS_VB + (size_t)NT * 512 * 2;
constexpr size_t WS_G = WS_BETA + (size_t)NT * 4 * 4;
constexpr size_t GREC = 73728;
constexpr int NREC = 1152;
constexpr size_t WS_GDN = WS_G + (size_t)NT * 4 * 4;
constexpr size_t WS_EGL = WS_GDN + (size_t)NREC * GREC;
constexpr size_t WS_MIX = WS_EGL + 8192;
constexpr size_t WS_X1 = WS_MIX + (size_t)NT * DM * 2;
constexpr size_t WS_ACT = WS_X1 + (size_t)NT * DM * 4;
constexpr size_t WS_PART4 = WS_ACT + (size_t)NT * DFF * 2;
constexpr size_t WS_PART7 = WS_PART4 + (size_t)4 * 256 * 1024 * 4;
constexpr size_t WS_END = WS_PART7 + (size_t)11 * 256 * 1024 * 4;

constexpr int LDS_BYTES = 163840;
constexpr int NTHR = 512;

struct Args { const float* in[19]; float* out; unsigned char* ws; int ph_lo, ph_hi; };

__device__ __forceinline__ int fresh_tid() { int t = threadIdx.x; asm volatile("" : "+v"(t)); return t; }
typedef __attribute__((ext_vector_type(2))) __bf16 hbf2;
typedef __attribute__((ext_vector_type(4))) unsigned u32x4;
__device__ __forceinline__ unsigned pack2(float a, float b) {
  f32x2 v; v[0] = a; v[1] = b;
  hbf2 r = __builtin_convertvector(v, hbf2);
  return __builtin_bit_cast(unsigned, r);
}
__device__ __forceinline__ u16 f2bf(float f) { return (u16)(pack2(f, 0.f) & 0xffffu); }
__device__ __forceinline__ float bf2f(u16 h) { return __uint_as_float(((unsigned)h) << 16); }
__device__ __forceinline__ float bflo(unsigned u) { return __uint_as_float(u << 16); }
__device__ __forceinline__ float bfhi(unsigned u) { return __uint_as_float(u & 0xffff0000u); }
__device__ __forceinline__ float silu_f(float x) { return x * __builtin_amdgcn_rcpf(1.f + __expf(-x)); }
__device__ __forceinline__ bf16x8 pack8(f32x4 a, f32x4 b) {
  u32x4 r; r[0] = pack2(a[0], a[1]); r[1] = pack2(a[2], a[3]); r[2] = pack2(b[0], b[1]); r[3] = pack2(b[2], b[3]);
  return __builtin_bit_cast(bf16x8, r);
}
__device__ __forceinline__ float wave_sum(float v) {
  v += __shfl_xor(v, 1); v += __shfl_xor(v, 2); v += __shfl_xor(v, 4);
  v += __shfl_xor(v, 8); v += __shfl_xor(v, 16); v += __shfl_xor(v, 32);
  return v;
}

constexpr int BM = 256, BK = 64, HALF = 128, HT = HALF * BK;
__device__ __forceinline__ int lds_byte(int r, int c) {
  int st = (r >> 4) * 2 + (c >> 5), rr = r & 15, cc = c & 31, ob = rr * 64 + cc * 2;
  return st * 1024 + (ob ^ (((ob >> 9) & 1) << 5));
}
__device__ __forceinline__ void stage_rc(int b, int& R, int& C) {
  int st = b / 1024, sb = b % 1024, swz = sb ^ (((sb >> 9) & 1) << 5);
  R = (st >> 1) * 16 + swz / 64; C = (st & 1) * 32 + (swz % 64) / 2;
}

template <class Epi>
__device__ __forceinline__ void gemm_tile(unsigned char* ldsraw, const u16* __restrict__ A, const u16* __restrict__ Bt,
                                          const int K, const int ldk, const int brow, const int bcol, Epi epi) {
  u16* shm = (u16*)ldsraw;
  const int gtid = fresh_tid();
#define SA(b, h) (shm + ((b) * 2 + (h)) * HT)
#define SB(b, h) (shm + (4 + (b) * 2 + (h)) * HT)
#define STAGE(P, BASE, br, kt) do { const u16* _gp = (BASE) + (long)(br) * ldk + (long)(kt) * BK; \
    __builtin_amdgcn_global_load_lds((const unsigned*)(_gp + soff0), (__attribute__((address_space(3))) unsigned*)((char*)(P) + gtid * 16), 16, 0, 0); \
    __builtin_amdgcn_global_load_lds((const unsigned*)(_gp + soff1), (__attribute__((address_space(3))) unsigned*)((char*)(P) + gtid * 16 + 8192), 16, 0, 0); } while (0)
#define LDA(dst, b, h) for (int m = 0; m < 4; ++m) for (int k = 0; k < 2; ++k) \
    dst[m][k] = *reinterpret_cast<const bf16x8*>((char*)SA(b, h) + lds_byte(wr * 64 + m * 16 + fr, k * 32 + fq * 8))
#define LDB(dst, b, h) for (int n = 0; n < 2; ++n) for (int k = 0; k < 2; ++k) \
    dst[n][k] = *reinterpret_cast<const bf16x8*>((char*)SB(b, h) + lds_byte(wc * 32 + n * 16 + fr, k * 32 + fq * 8))
#define MMA(ai, bj, At_, Bt_) do { __builtin_amdgcn_s_setprio(1); \
    for (int m = 0; m < 4; ++m) for (int n = 0; n < 2; ++n) for (int k = 0; k < 2; ++k) \
      acc[ai][bj][m][n] = __builtin_amdgcn_mfma_f32_16x16x32_bf16(At_[m][k], Bt_[n][k], acc[ai][bj][m][n], 0, 0, 0); \
    __builtin_amdgcn_s_setprio(0); } while (0)
#define WAIT_V(n) asm volatile("s_waitcnt vmcnt(" #n ")" ::: "memory")
#define WAIT_L(n) asm volatile("s_waitcnt lgkmcnt(" #n ")" ::: "memory")
#define BAR __builtin_amdgcn_s_barrier()
#define SCHED __builtin_amdgcn_sched_barrier(0)
  const int wid = gtid >> 6, lane = gtid & 63, wr = wid >> 2, wc = wid & 3, fr = lane & 15, fq = lane >> 4;
  int soff0, soff1;
  { int r_, c_; stage_rc(gtid * 16, r_, c_); soff0 = r_ * ldk + c_; stage_rc(gtid * 16 + 8192, r_, c_); soff1 = r_ * ldk + c_; }
  f32x4 acc[2][2][4][2];
#pragma unroll
  for (int i0 = 0; i0 < 2; ++i0)
#pragma unroll
    for (int i1 = 0; i1 < 2; ++i1)
#pragma unroll
      for (int i2 = 0; i2 < 4; ++i2)
#pragma unroll
        for (int i3 = 0; i3 < 2; ++i3) acc[i0][i1][i2][i3] = (f32x4){0.f, 0.f, 0.f, 0.f};
  bf16x8 At[4][2], B0[2][2], B1[2][2];
  const int nt = K / BK;
  STAGE(SB(0, 0), Bt, bcol, 0); STAGE(SA(0, 0), A, brow, 0);
  STAGE(SB(0, 1), Bt, bcol + HALF, 0); STAGE(SA(0, 1), A, brow + HALF, 0);
  if (wr == 1) BAR;
  WAIT_V(4); BAR;
  STAGE(SB(1, 0), Bt, bcol, 1); STAGE(SA(1, 0), A, brow, 1); STAGE(SB(1, 1), Bt, bcol + HALF, 1);
  WAIT_V(6); BAR;
  for (int t = 0; t < nt - 2; t += 2) {
    LDB(B0, 0, 0); SCHED; LDA(At, 0, 0); STAGE(SA(1, 1), A, brow + HALF, t + 1);
    WAIT_L(8); BAR; WAIT_L(0); MMA(0, 0, At, B0); BAR; SCHED;
    LDB(B1, 0, 1); STAGE(SB(0, 0), Bt, bcol, t + 2);
    BAR; WAIT_L(0); MMA(0, 1, At, B1); BAR;
    LDA(At, 0, 1); STAGE(SA(0, 0), A, brow, t + 2);
    BAR; WAIT_L(0); MMA(1, 0, At, B0); BAR; SCHED;
    STAGE(SB(0, 1), Bt, bcol + HALF, t + 2);
    WAIT_V(6); BAR; MMA(1, 1, At, B1); BAR;
    LDB(B0, 1, 0); SCHED; LDA(At, 1, 0); STAGE(SA(0, 1), A, brow + HALF, t + 2);
    WAIT_L(8); BAR; WAIT_L(0); MMA(0, 0, At, B0); BAR; SCHED;
    LDB(B1, 1, 1); STAGE(SB(1, 0), Bt, bcol, t + 3);
    BAR; WAIT_L(0); MMA(0, 1, At, B1); BAR;
    LDA(At, 1, 1); STAGE(SA(1, 0), A, brow, t + 3);
    BAR; WAIT_L(0); MMA(1, 0, At, B0); BAR; SCHED;
    STAGE(SB(1, 1), Bt, bcol + HALF, t + 3);
    WAIT_V(6); BAR; MMA(1, 1, At, B1); BAR;
  }
  { LDB(B0, 0, 0); LDA(At, 0, 0); STAGE(SA(1, 1), A, brow + HALF, nt - 1);
    BAR; WAIT_L(0); MMA(0, 0, At, B0); BAR;
    LDB(B1, 0, 1); BAR; WAIT_L(0); MMA(0, 1, At, B1); BAR;
    LDA(At, 0, 1); WAIT_V(4); BAR; WAIT_L(0); MMA(1, 0, At, B0); MMA(1, 1, At, B1); BAR; }
  { LDB(B0, 1, 0); LDA(At, 1, 0); WAIT_V(2); BAR; WAIT_L(0); MMA(0, 0, At, B0); BAR;
    LDB(B1, 1, 1); WAIT_V(0); BAR; WAIT_L(0); MMA(0, 1, At, B1); BAR;
    LDA(At, 1, 1); BAR; WAIT_L(0); MMA(1, 0, At, B0); MMA(1, 1, At, B1); BAR; }
  if (wr == 0) BAR;
#pragma unroll
  for (int ai = 0; ai < 2; ++ai)
#pragma unroll
    for (int bj = 0; bj < 2; ++bj)
#pragma unroll
      for (int m = 0; m < 4; ++m) {
        const int row0 = brow + ai * HALF + wr * 64 + m * 16 + fq * 4;
        const int col0 = bcol + bj * HALF + wc * 32 + fr;
        epi(acc[ai][bj][m][0], acc[ai][bj][m][1], row0, col0);
      }
  __syncthreads();
#undef SA
#undef SB
#undef STAGE
#undef LDA
#undef LDB
#undef MMA
}

constexpr int J_T0 = 480, J_T1 = J_T0 + 128, J_T2 = J_T1 + 704, J_T3 = J_T2 + 352;
constexpr int J_RMS = J_T3 + 1040;

__device__ __forceinline__ void p0_transpose(const Args& a, int job, unsigned char* lds) {
  float* tile = (float*)lds;
  const int tid = fresh_tid();
  int mat, nt_, kt_;
  if (job < J_T0) { mat = 0; nt_ = job / 16; kt_ = job % 16; }
  else if (job < J_T1) { mat = 1; int j = job - J_T0; nt_ = j / 16; kt_ = j % 16; }
  else if (job < J_T2) { mat = 2; int j = job - J_T1; nt_ = j / 16; kt_ = j % 16; }
  else { mat = 3; int j = job - J_T2; nt_ = j / 44; kt_ = j % 44; }
  const int n0 = nt_ * 128, k0 = kt_ * 64;
  const float* src; int ld, Kd; u16* dst;
  if (mat == 0) { src = a.in[7]; ld = INC; Kd = DM; dst = (u16*)(a.ws + WS_WIN); }
  else if (mat == 1) { src = a.in[13]; ld = DM; Kd = DM; dst = (u16*)(a.ws + WS_WOUT); }
  else if (mat == 2) { src = a.in[15]; ld = DFF; Kd = DM; dst = (u16*)(a.ws + WS_WGU); }
  else { src = a.in[17]; ld = DM; Kd = DFF; dst = (u16*)(a.ws + WS_WD); }
  float vals[16];
#pragma unroll
  for (int i = 0; i < 16; ++i) {
    int e = tid + 512 * i; int kl = e >> 7, nl = e & 127; int n = n0 + nl; int col; const float* s = src;
    bool zero_ = false;
    if (mat == 0) { if (n < 2048) col = n; else if (n < 3584) col = n + 8; else if (n < 3592) col = 2048 + (n - 3584); else { col = 0; zero_ = true; } }
    else if (mat == 2) { int t256 = n >> 8, bj = (n >> 7) & 1, wc = (n >> 5) & 3, nn = (n >> 4) & 1, fr = n & 15;
      col = t256 * 128 + bj * 64 + wc * 16 + fr; if (nn) s = a.in[16]; }
    else col = n;
    vals[i] = zero_ ? 0.f : s[(size_t)(k0 + kl) * ld + col];
  }
#pragma unroll
  for (int i = 0; i < 16; ++i) { int e = tid + 512 * i; tile[(e >> 7) * 129 + (e & 127)] = vals[i]; }
  __syncthreads();
  {
    int nl = tid >> 2, k16 = (tid & 3) * 16;
    bf16x8 v0, v1;
#pragma unroll
    for (int i = 0; i < 8; ++i) { v0[i] = (short)f2bf(tile[(k16 + i) * 129 + nl]); v1[i] = (short)f2bf(tile[(k16 + 8 + i) * 129 + nl]); }
    bf16x8* dp = reinterpret_cast<bf16x8*>(dst + (size_t)(n0 + nl) * Kd + k0 + k16);
    dp[0] = v0; dp[1] = v1;
  }
  __syncthreads();
}

template <int MODE>
__device__ __forceinline__ void rms_row_bf16(const Args& a, const float* __restrict__ xrow, const float* __restrict__ nw,
                                             u16* __restrict__ hrow, int row) {
  const int lane = fresh_tid() & 63;
  f32x4 x[4];
  float ss = 0.f;
#pragma unroll
  for (int i = 0; i < 4; ++i) {
    x[i] = *reinterpret_cast<const f32x4*>(xrow + (i * 64 + lane) * 4);
    ss += x[i][0] * x[i][0] + x[i][1] * x[i][1] + x[i][2] * x[i][2] + x[i][3] * x[i][3];
  }
  ss = wave_sum(ss);
  const float rstd = rsqrtf(ss * (1.f / 1024.f) + EPS);
  float dot[8];
  if (MODE == 0) {
#pragma unroll
    for (int c = 0; c < 8; ++c) dot[c] = 0.f;
  }
#pragma unroll
  for (int i = 0; i < 4; ++i) {
    f32x4 w = *reinterpret_cast<const f32x4*>(nw + (i * 64 + lane) * 4);
    f32x4 h;
    h[0] = x[i][0] * rstd * w[0]; h[1] = x[i][1] * rstd * w[1]; h[2] = x[i][2] * rstd * w[2]; h[3] = x[i][3] * rstd * w[3];
    uint2 pk; pk.x = pack2(h[0], h[1]); pk.y = pack2(h[2], h[3]);
    *reinterpret_cast<uint2*>(hrow + (i * 64 + lane) * 4) = pk;
    if (MODE == 0) {
      const float* wi = a.in[7];
#pragma unroll
      for (int e = 0; e < 4; ++e) {
        int k = (i * 64 + lane) * 4 + e;
        f32x4 w0 = *reinterpret_cast<const f32x4*>(wi + (size_t)k * INC + 2048);
        f32x4 w1 = *reinterpret_cast<const f32x4*>(wi + (size_t)k * INC + 2052);
        dot[0] += h[e] * w0[0]; dot[1] += h[e] * w0[1]; dot[2] += h[e] * w0[2]; dot[3] += h[e] * w0[3];
        dot[4] += h[e] * w1[0]; dot[5] += h[e] * w1[1]; dot[6] += h[e] * w1[2]; dot[7] += h[e] * w1[3];
      }
    }
  }
  if (MODE == 0) {
#pragma unroll
    for (int c = 0; c < 8; ++c) dot[c] = wave_sum(dot[c]);
    float* BETA = (float*)(a.ws + WS_BETA); float* G = (float*)(a.ws + WS_G);
    if (lane < 4) {
      float bv = (lane == 0) ? dot[0] : (lane == 1) ? dot[1] : (lane == 2) ? dot[2] : dot[3];
      float av = (lane == 0) ? dot[4] : (lane == 1) ? dot[5] : (lane == 2) ? dot[6] : dot[7];
      float beta = 1.f / (1.f + expf(-bv));
      float xx = av + a.in[10][lane];
      float sp = (xx > 20.f) ? xx : log1pf(expf(xx));
      float g = -expf(a.in[9][lane]) * sp;
      BETA[row * 4 + lane] = beta; G[row * 4 + lane] = g;
    }
  }
}

__device__ __forceinline__ void rms_row_b2b(const u16* xrow, const float* nw, u16* hrow) {
  const int lane = fresh_tid() & 63;
  f32x4 x[4]; float ss = 0.f;
#pragma unroll
  for (int i = 0; i < 4; ++i) {
    const uint2 u = *reinterpret_cast<const uint2*>(xrow + (i * 64 + lane) * 4);
    x[i] = (f32x4){bflo(u.x), bfhi(u.x), bflo(u.y), bfhi(u.y)};
    ss += x[i][0] * x[i][0] + x[i][1] * x[i][1] + x[i][2] * x[i][2] + x[i][3] * x[i][3];
  }
  ss = wave_sum(ss);
  const float rstd = rsqrtf(ss * (1.f / 1024.f) + EPS);
#pragma unroll
  for (int i = 0; i < 4; ++i) {
    f32x4 w = *reinterpret_cast<const f32x4*>(nw + (i * 64 + lane) * 4);
    uint2 pk; pk.x = pack2(x[i][0] * rstd * w[0], x[i][1] * rstd * w[1]); pk.y = pack2(x[i][2] * rstd * w[2], x[i][3] * rstd * w[3]);
    *reinterpret_cast<uint2*>(hrow + (i * 64 + lane) * 4) = pk;
  }
}
__device__ __forceinline__ void phase0(const Args& a, unsigned char* lds) {
  const int tid = fresh_tid(), wave = tid >> 6;
  const bool defer = (gridDim.x == 256);
  for (int job = blockIdx.x; job < J_RMS; job += gridDim.x) {
    if (defer && job >= J_T0 && job < J_T3) continue;
    if (job < J_T3) p0_transpose(a, job, lds);
    else {
#pragma unroll
      for (int rr = 0; rr < 2; ++rr) {
        int row = (job - J_T3) * 16 + wave * 2 + rr;
        const float* xr = (row < NPR) ? a.in[0] + (size_t)row * DM : a.in[1] + (size_t)(row - NPR) * DM;
        rms_row_bf16<1>(a, xr, a.in[6], (u16*)(a.ws + WS_H) + (size_t)row * DM, row);
      }
    }
  }
}
__device__ __forceinline__ void copy_range(const Args& a, int j0, int j1, int first, int stride, int tid);
__device__ __forceinline__ void copy_job(const Args& a, int jb, int tid) {
#pragma unroll
  for (int i = 0; i < 8; ++i) {
    int idx = jb * 4096 + i * 512 + tid;
    int ab = idx / 261120, off = idx - ab * 261120;
    int arr = ab >> 5, b = ab & 31;
    const float* src = (arr ? a.in[5] : a.in[4]) + (size_t)b * 1048576 + 4096 + (size_t)off * 4;
    float* dst = a.out + (arr ? O_WVS : O_WKS) + (size_t)b * 1048576 + (size_t)off * 4;
    f32x4 v = __builtin_nontemporal_load(reinterpret_cast<const f32x4*>(src));
    __builtin_nontemporal_store(v, reinterpret_cast<f32x4*>(dst));
  }
}

__device__ __forceinline__ void copy_range(const Args& a, int j0, int j1, int first, int stride, int tid) {
  int jb = j0 + first;
  for (; jb + stride < j1; jb += 2 * stride) {
    f32x4 v[16];
#pragma unroll
    for (int i = 0; i < 16; ++i) {
      int idx = ((i < 8) ? jb : jb + stride) * 4096 + (i & 7) * 512 + tid;
      int ab = idx / 261120, off = idx - ab * 261120; int arr = ab >> 5, b = ab & 31;
      const float* src = (arr ? a.in[5] : a.in[4]) + (size_t)b * 1048576 + 4096 + (size_t)off * 4;
      v[i] = __builtin_nontemporal_load(reinterpret_cast<const f32x4*>(src));
    }
#pragma unroll
    for (int i = 0; i < 16; ++i) {
      int idx = ((i < 8) ? jb : jb + stride) * 4096 + (i & 7) * 512 + tid;
      int ab = idx / 261120, off = idx - ab * 261120; int arr = ab >> 5, b = ab & 31;
      float* dst = a.out + (arr ? O_WVS : O_WKS) + (size_t)b * 1048576 + (size_t)off * 4;
      __builtin_nontemporal_store(v[i], reinterpret_cast<f32x4*>(dst));
    }
  }
  if (jb < j1) copy_job(a, jb, tid);
}
typedef unsigned long long u64;
__device__ __forceinline__ void st_wt16(void* p, bf16x8 v) {
  typedef __attribute__((ext_vector_type(2))) u64 u64x2;
  u64x2 q = __builtin_bit_cast(u64x2, v);
  __hip_atomic_store((u64*)p, q[0], __ATOMIC_RELAXED, __HIP_MEMORY_SCOPE_AGENT);
  __hip_atomic_store((u64*)p + 1, q[1], __ATOMIC_RELAXED, __HIP_MEMORY_SCOPE_AGENT);
}
__device__ __forceinline__ void st_wt8(void* p, bf16x4 v) {
  __hip_atomic_store((u64*)p, __builtin_bit_cast(u64, v), __ATOMIC_RELAXED, __HIP_MEMORY_SCOPE_AGENT);
}
template <class G>
__device__ __forceinline__ void emit_frag(bf16x8* __restrict__ dst, int nR, int nKs, G get) {
  const int total = nR * nKs * 64;
  for (int idx = fresh_tid(); idx < total; idx += NTHR) {
    int f = idx >> 6, l = idx & 63; int R = f / nKs, ks = f - R * nKs; int m = l & 15, kg = l >> 4;
    int row = 16 * R + m, c0 = 32 * ks + 4 * kg;
    bf16x8 v;
#pragma unroll
    for (int j = 0; j < 4; ++j) { v[j] = (short)f2bf(get(row, c0 + j)); v[4 + j] = (short)f2bf(get(row, c0 + 16 + j)); }
    st_wt16(dst + idx, v);
  }
}

__device__ __forceinline__ void gdn_prep_item(const Args& a, int item, unsigned char* lds) {
  float* Kf = (float*)lds;
  float* Qf = Kf + 64 * 132;
  float* Vb = Qf + 64 * 132;
  float* Lm = Vb + 64 * 132;
  float* QKm = Lm + 64 * 68;
  float* gc = QKm + 64 * 68;
  float* bet = gc + 64;
  float* gg = bet + 64;
  float* Ti = gg + 64;
  const int tid = fresh_tid(), lane = tid & 63, wave = tid >> 6;
  const bool samp = item >= 1024;
  int b, h, ch, row0, ntok;
  if (!samp) { int bh = item >> 6; ch = item & 63; b = bh >> 2; h = bh & 3; row0 = b * SEQ + ch * 64; ntok = 64; }
  else { int s = item - 1024; b = s >> 2; h = s & 3; ch = 0; row0 = NPR + b * 8; ntok = 8; }
  const u16* QKVA = (const u16*)(a.ws + WS_QKVA);
  const float* BETA = (const float*)(a.ws + WS_BETA);
  const float* Gg = (const float*)(a.ws + WS_G);
  unsigned char* rec = a.ws + WS_GDN + (size_t)item * GREC;
  {
    const int t0 = wave * 8;
    float betv[8];
#pragma unroll
    for (int i = 0; i < 8; ++i) {
      const int t = t0 + i; float be = 0.f, g = 0.f;
      if (t < ntok) { be = BETA[(row0 + t) * 4 + h]; g = Gg[(row0 + t) * 4 + h]; }
      betv[i] = be;
      if (lane == 0) { bet[t] = be; gg[t] = g; }
    }
#pragma unroll
    for (int seg = 0; seg < 3; ++seg) {
      const int cb = seg * 512 + h * 128 + 2 * lane;
      float* dstm = (seg == 0) ? Qf : (seg == 1) ? Kf : Vb;
      float w0[4], w1[4];
#pragma unroll
      for (int i = 0; i < 4; ++i) { f32x2 ww = *reinterpret_cast<const f32x2*>(a.in[8] + i * CONVD + cb); w0[i] = ww[0]; w1[i] = ww[1]; }
      float r0[11], r1[11];
#pragma unroll
      for (int i = 0; i < 11; ++i) {
        int tk = t0 - 3 + i;
        float v0 = 0.f, v1 = 0.f;
        if (!samp) {
          int pos = ch * 64 + tk;
          if (pos >= 0) { unsigned u = *reinterpret_cast<const unsigned*>(QKVA + (size_t)(b * SEQ + pos) * CONVD + cb); v0 = bflo(u); v1 = bfhi(u); }
        } else {
          if (tk < 0) { f32x2 sv = *reinterpret_cast<const f32x2*>(a.in[2] + (size_t)(b * 3 + 3 + tk) * CONVD + cb); v0 = sv[0]; v1 = sv[1]; }
          else if (tk < 8) { unsigned u = *reinterpret_cast<const unsigned*>(QKVA + (size_t)(NPR + b * 8 + tk) * CONVD + cb); v0 = bflo(u); v1 = bfhi(u); }
        }
        r0[i] = v0; r1[i] = v1;
      }
#pragma unroll
      for (int i = 0; i < 8; ++i) {
        const int t = t0 + i;
        float c0 = silu_f(r0[i] * w0[0] + r0[i + 1] * w0[1] + r0[i + 2] * w0[2] + r0[i + 3] * w0[3]);
        float c1 = silu_f(r1[i] * w1[0] + r1[i + 1] * w1[1] + r1[i + 2] * w1[2] + r1[i + 3] * w1[3]);
        float sc = (t < ntok) ? ((seg == 2) ? betv[i] : 1.f) : 0.f;
        f32x2 o2; o2[0] = c0 * sc; o2[1] = c1 * sc;
        *reinterpret_cast<f32x2*>(dstm + t * 132 + 2 * lane) = o2;
      }
    }
  }
  __syncthreads();
  {
    const int tok = tid >> 3, part = tid & 7;
    float* qp = Qf + tok * 132 + 16 * part; float* kp = Kf + tok * 132 + 16 * part;
    f32x4 qv[4], kv[4]; float sq = 0.f, sk = 0.f;
#pragma unroll
    for (int i = 0; i < 4; ++i) {
      qv[i] = *reinterpret_cast<const f32x4*>(qp + 4 * i); kv[i] = *reinterpret_cast<const f32x4*>(kp + 4 * i);
      sq += qv[i][0] * qv[i][0] + qv[i][1] * qv[i][1] + qv[i][2] * qv[i][2] + qv[i][3] * qv[i][3];
      sk += kv[i][0] * kv[i][0] + kv[i][1] * kv[i][1] + kv[i][2] * kv[i][2] + kv[i][3] * kv[i][3];
    }
    sq += __shfl_xor(sq, 1); sq += __shfl_xor(sq, 2); sq += __shfl_xor(sq, 4);
    sk += __shfl_xor(sk, 1); sk += __shfl_xor(sk, 2); sk += __shfl_xor(sk, 4);
    const float rq = rsqrtf(sq + EPS) * 0.08838834764831845f, rk = rsqrtf(sk + EPS);
#pragma unroll
    for (int i = 0; i < 4; ++i) {
      *reinterpret_cast<f32x4*>(qp + 4 * i) = qv[i] * rq;
      *reinterpret_cast<f32x4*>(kp + 4 * i) = kv[i] * rk;
    }
    if (wave == 0) {
      float x = gg[lane];
#pragma unroll
      for (int off = 1; off < 64; off <<= 1) { float y = __shfl_up(x, off); if (lane >= off) x += y; }
      gc[lane] = x;
    }
  }
  __syncthreads();
  {
    const int m = lane & 15, kq = lane >> 4;
    const int ct = wave >> 1;
#pragma unroll
    for (int ss = 0; ss < 2; ++ss) {
      const int st = (wave & 1) * 2 + ss;
      f32x4 akk = (f32x4){0.f, 0.f, 0.f, 0.f}, aqk = (f32x4){0.f, 0.f, 0.f, 0.f};
      if (st <= ct) {
        const float* kap = Kf + (16 * ct + m) * 132 + 4 * kq;
        const float* qap = Qf + (16 * ct + m) * 132 + 4 * kq;
        const float* kbp = Kf + (16 * st + m) * 132 + 4 * kq;
#pragma unroll
        for (int blk = 0; blk < 8; ++blk) {
          f32x4 ka = *reinterpret_cast<const f32x4*>(kap + 16 * blk);
          f32x4 qa = *reinterpret_cast<const f32x4*>(qap + 16 * blk);
          f32x4 kb = *reinterpret_cast<const f32x4*>(kbp + 16 * blk);
#pragma unroll
          for (int t = 0; t < 4; ++t) {
            akk = __builtin_amdgcn_mfma_f32_16x16x4f32(ka[t], kb[t], akk, 0, 0, 0);
            aqk = __builtin_amdgcn_mfma_f32_16x16x4f32(qa[t], kb[t], aqk, 0, 0, 0);
          }
        }
      }
      const int s = 16 * st + m;
      const float gcs = gc[s];
#pragma unroll
      for (int j = 0; j < 4; ++j) {
        const int c = 16 * ct + 4 * kq + j;
        float arg = (s <= c) ? (gc[c] - gcs) : 0.f;
        float dec = __expf(arg);
        Lm[c * 68 + s] = (s < c) ? bet[c] * akk[j] * dec : 0.f;
        QKm[c * 68 + s] = (s <= c) ? aqk[j] * dec : 0.f;
      }
    }
  }
  __syncthreads();
  {
    const float gl = gc[63];
    emit_frag((bf16x8*)(rec + 16384), 4, 4, [&](int row, int col) { return Qf[row * 132 + col] * __expf(gc[row]); });
    emit_frag((bf16x8*)(rec + 32768), 8, 2, [&](int row, int col) { return Kf[col * 132 + row] * __expf(gl - gc[col]); });
    emit_frag((bf16x8*)(rec + 49152), 4, 2, [&](int row, int col) { return QKm[row * 68 + col]; });
    if (tid >= 64 && tid < 128) { f32x4 e4 = (f32x4){__expf(gl), __expf(gl), __expf(gl), __expf(gl)}; st_wt16(rec + 49152 + 1024 + (tid - 64) * 16, __builtin_bit_cast(bf16x8, e4)); }
  }
  __syncthreads();
  if (wave == 0) {
    const int blk = lane >> 4, jc = lane & 15;
    float x[16];
#pragma unroll
    for (int r = 0; r < 16; ++r) x[r] = 0.f;
#pragma unroll
    for (int r = 0; r < 16; ++r) {
      float acc = (r == jc) ? 1.f : 0.f;
#pragma unroll
      for (int q = 0; q < (r + 3) / 4; ++q) {
        f32x4 l4 = *reinterpret_cast<const f32x4*>(Lm + (16 * blk + r) * 68 + 16 * blk + 4 * q);
        acc -= l4[0] * x[4 * q] + l4[1] * x[4 * q + 1] + l4[2] * x[4 * q + 2] + l4[3] * x[4 * q + 3];
      }
      x[r] = acc;
    }
#pragma unroll
    for (int r = 0; r < 16; ++r) Ti[blk * 320 + r * 20 + jc] = x[r];
  } else {
    for (int idx = tid - 64; idx < 64 * 128; idx += 448) {
      const int c = idx >> 7, col = idx & 127;
      Qf[c * 132 + col] = Kf[c * 132 + col] * bet[c] * __expf(gc[c]);
    }
  }
  __syncthreads();
  {
    const int m = lane & 15, kq = lane >> 4;
    float* R = (wave < 4) ? Vb : Qf;
    const int cbase = 32 * (wave & 3);
    f32x4 X[4][2];
#pragma unroll
    for (int i = 0; i < 4; ++i) {
      f32x4 Y[2];
#pragma unroll
      for (int nt = 0; nt < 2; ++nt)
#pragma unroll
        for (int j = 0; j < 4; ++j) Y[nt][j] = R[(16 * i + 4 * kq + j) * 132 + cbase + 16 * nt + m];
#pragma unroll
      for (int p = 0; p < i; ++p) {
        f32x4 l4 = *reinterpret_cast<const f32x4*>(Lm + (16 * i + m) * 68 + 16 * p + 4 * kq);
#pragma unroll
        for (int t = 0; t < 4; ++t)
#pragma unroll
          for (int nt = 0; nt < 2; ++nt) Y[nt] = __builtin_amdgcn_mfma_f32_16x16x4f32(-l4[t], X[p][nt][t], Y[nt], 0, 0, 0);
      }
      f32x4 t4 = *reinterpret_cast<const f32x4*>(Ti + i * 320 + m * 20 + 4 * kq);
#pragma unroll
      for (int nt = 0; nt < 2; ++nt) {
        f32x4 zacc = (f32x4){0.f, 0.f, 0.f, 0.f};
#pragma unroll
        for (int t = 0; t < 4; ++t) zacc = __builtin_amdgcn_mfma_f32_16x16x4f32(t4[t], Y[nt][t], zacc, 0, 0, 0);
        X[i][nt] = zacc;
      }
    }
    if (wave < 4) {
      bf16x4* UF = (bf16x4*)(rec + 57344);
#pragma unroll
      for (int i = 0; i < 4; ++i)
#pragma unroll
        for (int nt = 0; nt < 2; ++nt) {
          bf16x4 u4; u4[0] = (short)f2bf(X[i][nt][0]); u4[1] = (short)f2bf(X[i][nt][1]); u4[2] = (short)f2bf(X[i][nt][2]); u4[3] = (short)f2bf(X[i][nt][3]);
          st_wt8(UF + ((2 * wave + nt) * 4 + i) * 64 + lane, u4);
        }
    } else {
#pragma unroll
      for (int i = 0; i < 4; ++i)
#pragma unroll
        for (int nt = 0; nt < 2; ++nt)
#pragma unroll
          for (int j = 0; j < 4; ++j) Qf[(16 * i + 4 * kq + j) * 132 + cbase + 16 * nt + m] = X[i][nt][j];
    }
  }
  __syncthreads();
  emit_frag((bf16x8*)(rec), 4, 4, [&](int row, int col) { return -Qf[row * 132 + col]; });
  asm volatile("s_waitcnt vmcnt(0)" ::: "memory");
  __syncthreads();
  if (tid == 0) __hip_atomic_store((int*)(a.ws + WS_CTL) + item, 1, __ATOMIC_RELAXED, __HIP_MEMORY_SCOPE_AGENT);
}

#define AS3 __attribute__((address_space(3)))
constexpr int SCAN_BUF = 57344;
__device__ __forceinline__ void scan_wait(const int* flags, int c, int nch, int& known) {
  if (known > c) return;
  const int lane = threadIdx.x & 63;
  while (known <= c) {
    const int idx = known + lane;
    int f = 0;
    if (lane < 16) f = (idx < nch) ? __hip_atomic_load(flags + idx, __ATOMIC_RELAXED, __HIP_MEMORY_SCOPE_AGENT) : 1;
    const unsigned long long m = __ballot(f != 0);
    const int cnt = __builtin_ctzll(~m);
    if (cnt == 0) __builtin_amdgcn_s_sleep(8);
    known += (cnt > 16) ? 16 : cnt;
  }
  __builtin_amdgcn_fence(__ATOMIC_ACQUIRE, "agent");
}
__device__ __forceinline__ void scan_dma(const unsigned char* rec, unsigned char* fbuf, unsigned char* ubuf, int t256) {
#pragma unroll
  for (int i = 0; i < 14; ++i)
    __builtin_amdgcn_global_load_lds((const unsigned*)(rec + (i * 256 + t256) * 16), (AS3 unsigned*)(fbuf + (i * 256 + t256) * 16), 16, 0, 0);
#pragma unroll
  for (int i = 0; i < 4; ++i)
    __builtin_amdgcn_global_load_lds((const unsigned*)(rec + 57344 + (i * 256 + t256) * 16), (AS3 unsigned*)(ubuf + (i * 256 + t256) * 16), 16, 0, 0);
}
__device__ __forceinline__ void gdn_scan_item(const Args& a, int sitem, unsigned char* lds) {
  unsigned char* Ub = lds + 2 * SCAN_BUF;
  u16* Ot = (u16*)(lds + 2 * SCAN_BUF + 32768);
  const int tid = fresh_tid(), lane = tid & 63, w = tid >> 6, n = lane & 15, rg = lane >> 4;
  const bool mw = w < 4;
  const bool samp = sitem >= 16;
  int bb, h, nch, rec0, rowbase; size_t orec;
  if (!samp) { bb = sitem >> 2; h = sitem & 3; nch = 64; rec0 = sitem * 64; rowbase = bb * SEQ; orec = O_RECP + (size_t)sitem * 16384; }
  else { int s = sitem - 16; bb = s >> 2; h = s & 3; nch = 1; rec0 = 1024 + s; rowbase = NPR + bb * 8; orec = O_RECS + (size_t)s * 16384; }
  const u16* Z = (const u16*)(a.ws + WS_Z);
  u16* MIX = (u16*)(a.ws + WS_MIX);
  const unsigned char* recb = a.ws + WS_GDN + (size_t)rec0 * GREC;
  __syncthreads();
  if (mw) {
    f32x4 S[8][2];
#pragma unroll
    for (int i = 0; i < 8; ++i) { S[i][0] = (f32x4){0.f, 0.f, 0.f, 0.f}; S[i][1] = (f32x4){0.f, 0.f, 0.f, 0.f}; }
    if (samp) {
      const float* sp = a.in[3] + (size_t)(sitem - 16) * 16384 + (4 * rg) * 128 + 32 * w + n;
#pragma unroll
      for (int i = 0; i < 8; ++i)
#pragma unroll
        for (int nt = 0; nt < 2; ++nt)
#pragma unroll
          for (int j = 0; j < 4; ++j) S[i][nt][j] = sp[(16 * i + j) * 128 + 16 * nt];
    }
    const int* flags = (const int*)(a.ws + WS_CTL) + rec0;
    int known = 0;
    scan_wait(flags, 0, nch, known);
    scan_dma(recb, lds, Ub, tid);
#pragma unroll 1
    for (int ch = 0; ch < nch; ++ch) {
      asm volatile("s_waitcnt vmcnt(0)" ::: "memory");
      __syncthreads();
      const unsigned char* bufp = lds + (ch & 1) * SCAN_BUF;
      const unsigned char* ubp = Ub + (ch & 1) * 16384;
      if (ch + 1 < nch) {
        scan_wait(flags, ch + 1, nch, known);
        scan_dma(recb + (size_t)(ch + 1) * GREC, lds + ((ch + 1) & 1) * SCAN_BUF, Ub + ((ch + 1) & 1) * 16384, tid);
      }
      const float egl = *(const float*)(bufp + 49152 + 1024);
      const bf16x8* WF = (const bf16x8*)bufp; const bf16x8* QGF = (const bf16x8*)(bufp + 16384);
      const bf16x8* KDF = (const bf16x8*)(bufp + 32768); const bf16x8* QKF = (const bf16x8*)(bufp + 49152);
      f32x4 e[4][2], o[4][2];
#pragma unroll
      for (int tt = 0; tt < 4; ++tt)
#pragma unroll
        for (int nt = 0; nt < 2; ++nt) {
          const uint2 u2 = ((const uint2*)ubp)[((2 * w + nt) * 4 + tt) * 64 + lane];
          e[tt][nt] = (f32x4){bflo(u2.x), bfhi(u2.x), bflo(u2.y), bfhi(u2.y)};
          o[tt][nt] = (f32x4){0.f, 0.f, 0.f, 0.f};
        }
#pragma unroll
      for (int ks = 0; ks < 4; ++ks) {
        const bf16x8 Sb0 = pack8(S[2 * ks][0], S[2 * ks + 1][0]);
        const bf16x8 Sb1 = pack8(S[2 * ks][1], S[2 * ks + 1][1]);
#pragma unroll
        for (int tt = 0; tt < 4; ++tt) {
          bf16x8 af = WF[(tt * 4 + ks) * 64 + lane];
          e[tt][0] = __builtin_amdgcn_mfma_f32_16x16x32_bf16(af, Sb0, e[tt][0], 0, 0, 0);
          e[tt][1] = __builtin_amdgcn_mfma_f32_16x16x32_bf16(af, Sb1, e[tt][1], 0, 0, 0);
        }
#pragma unroll
        for (int tc = 0; tc < 4; ++tc) {
          bf16x8 af = QGF[(tc * 4 + ks) * 64 + lane];
          o[tc][0] = __builtin_amdgcn_mfma_f32_16x16x32_bf16(af, Sb0, o[tc][0], 0, 0, 0);
          o[tc][1] = __builtin_amdgcn_mfma_f32_16x16x32_bf16(af, Sb1, o[tc][1], 0, 0, 0);
        }
      }
      bf16x8 eb[2][2];
#pragma unroll
      for (int kt = 0; kt < 2; ++kt)
#pragma unroll
        for (int nt = 0; nt < 2; ++nt) eb[kt][nt] = pack8(e[2 * kt][nt], e[2 * kt + 1][nt]);
#pragma unroll
      for (int tc = 0; tc < 4; ++tc) {
#pragma unroll
        for (int kt = 0; kt < 2; ++kt) {
          if (tc == 0 && kt == 1) continue;
          bf16x8 af = QKF[(tc * 2 + kt) * 64 + lane];
          o[tc][0] = __builtin_amdgcn_mfma_f32_16x16x32_bf16(af, eb[kt][0], o[tc][0], 0, 0, 0);
          o[tc][1] = __builtin_amdgcn_mfma_f32_16x16x32_bf16(af, eb[kt][1], o[tc][1], 0, 0, 0);
        }
      }
      __syncthreads();
#pragma unroll
      for (int tc = 0; tc < 4; ++tc)
#pragma unroll
        for (int nt = 0; nt < 2; ++nt)
#pragma unroll
          for (int j = 0; j < 4; ++j) { const int row = 16 * tc + 4 * rg + j; Ot[row * 128 + 16 * ((2 * w + nt) ^ (row & 7)) + n] = f2bf(o[tc][nt][j]); }
#pragma unroll
      for (int i = 0; i < 8; ++i) {
        f32x4 ac0 = S[i][0] * egl, ac1 = S[i][1] * egl;
#pragma unroll
        for (int kt = 0; kt < 2; ++kt) {
          bf16x8 af = KDF[(i * 2 + kt) * 64 + lane];
          ac0 = __builtin_amdgcn_mfma_f32_16x16x32_bf16(af, eb[kt][0], ac0, 0, 0, 0);
          ac1 = __builtin_amdgcn_mfma_f32_16x16x32_bf16(af, eb[kt][1], ac1, 0, 0, 0);
        }
        S[i][0] = ac0; S[i][1] = ac1;
      }
    }
    __syncthreads();
#pragma unroll
    for (int i = 0; i < 8; ++i)
#pragma unroll
      for (int nt = 0; nt < 2; ++nt)
#pragma unroll
        for (int j = 0; j < 4; ++j) a.out[orec + (16 * i + 4 * rg + j) * 128 + 32 * w + 16 * nt + n] = S[i][nt][j];
  } else {
    const int t = tid - 256, otok = t >> 2, oq = t & 3;
    const bool ovalid = samp ? (otok < 8) : true;
    float nw[32];
#pragma unroll
    for (int i = 0; i < 8; ++i) { f32x4 w4 = *reinterpret_cast<const f32x4*>(a.in[11] + 32 * oq + 4 * i); nw[4 * i] = w4[0]; nw[4 * i + 1] = w4[1]; nw[4 * i + 2] = w4[2]; nw[4 * i + 3] = w4[3]; }
    const size_t zoff = (size_t)(rowbase + (ovalid ? otok : 0)) * 512 + h * 128 + 32 * oq;
    uint4 zr[4];
    { const uint4* zp = reinterpret_cast<const uint4*>(Z + zoff);
#pragma unroll
      for (int i = 0; i < 4; ++i) zr[i] = zp[i]; }
#pragma unroll 1
    for (int ch = 0; ch <= nch; ++ch) {
      if (ch < nch) __syncthreads();
      uint4 ot[4];
      if (ch == nch) __syncthreads();
      if (ch > 0) {
#pragma unroll
        for (int gq = 0; gq < 2; ++gq) {
          const uint4* orp = reinterpret_cast<const uint4*>(Ot + otok * 128 + 16 * ((2 * oq + gq) ^ (otok & 7)));
          ot[2 * gq] = orp[0]; ot[2 * gq + 1] = orp[1];
        }
      }
      if (ch < nch) __syncthreads();
      if (ch > 0) {
        const int orow = rowbase + (ch - 1) * 64 + (ovalid ? otok : 0);
        const unsigned ov[16] = {ot[0].x, ot[0].y, ot[0].z, ot[0].w, ot[1].x, ot[1].y, ot[1].z, ot[1].w,
                                 ot[2].x, ot[2].y, ot[2].z, ot[2].w, ot[3].x, ot[3].y, ot[3].z, ot[3].w};
        const unsigned zz[16] = {zr[0].x, zr[0].y, zr[0].z, zr[0].w, zr[1].x, zr[1].y, zr[1].z, zr[1].w,
                                 zr[2].x, zr[2].y, zr[2].z, zr[2].w, zr[3].x, zr[3].y, zr[3].z, zr[3].w};
        if (ch < nch) {
          const uint4* zp = reinterpret_cast<const uint4*>(Z + zoff + (size_t)ch * 64 * 512);
#pragma unroll
          for (int i = 0; i < 4; ++i) zr[i] = zp[i];
        }
        float ss = 0.f;
#pragma unroll
        for (int q = 0; q < 16; ++q) { float x0 = bflo(ov[q]), x1 = bfhi(ov[q]); ss += x0 * x0 + x1 * x1; }
        ss += __shfl_xor(ss, 1); ss += __shfl_xor(ss, 2);
        const float rstd = rsqrtf(ss * (1.f / 128.f) + EPS);
        unsigned outp[16];
#pragma unroll
        for (int q = 0; q < 16; ++q) {
          float oa = bflo(ov[q]) * rstd * nw[2 * q] * silu_f(bflo(zz[q]));
          float ob = bfhi(ov[q]) * rstd * nw[2 * q + 1] * silu_f(bfhi(zz[q]));
          outp[q] = pack2(oa, ob);
        }
        if (ovalid) {
          uint4* op = reinterpret_cast<uint4*>(MIX + (size_t)orow * DM + h * 128 + 32 * oq);
#pragma unroll
          for (int i = 0; i < 4; ++i) op[i] = make_uint4(outp[4 * i], outp[4 * i + 1], outp[4 * i + 2], outp[4 * i + 3]);
        }
      }
    }
  }
  __syncthreads();
}

struct KVRegs { bf16x8 k[4], v[4]; };
__device__ __forceinline__ void attn_fetch(const Args& a, KVRegs& R, bool samp, int bb, int h, int krow0, int C0, int tid, int br) {
  const u16* KB = (const u16*)(a.ws + WS_KB);
  const u16* VB = (const u16*)(a.ws + WS_VB);
#pragma unroll
  for (int i = 0; i < 4; ++i) {
    const int idx = tid + 512 * i; const int tl = idx >> 3, seg = idx & 7; const int p = C0 + tl;
    bf16x8 kv = (bf16x8){0, 0, 0, 0, 0, 0, 0, 0}, vv = (bf16x8){0, 0, 0, 0, 0, 0, 0, 0};
    if (!samp) {
      kv = *reinterpret_cast<const bf16x8*>(KB + (size_t)(krow0 + p) * 512 + h * 64 + seg * 8);
      vv = *reinterpret_cast<const bf16x8*>(VB + (size_t)(krow0 + p) * 512 + h * 64 + seg * 8);
    } else if ((br == 0 && (tl & 15) >= 8) || (br == 2 && p < 1920)) {
    } else if (p < 2048) {
      const float* kp = a.in[4] + ((size_t)(bb * 2048 + p) * 8 + h) * 64 + seg * 8;
      const float* vp = a.in[5] + ((size_t)(bb * 2048 + p) * 8 + h) * 64 + seg * 8;
      f32x4 k0 = *reinterpret_cast<const f32x4*>(kp), k1 = *reinterpret_cast<const f32x4*>(kp + 4);
      f32x4 v0 = *reinterpret_cast<const f32x4*>(vp), v1 = *reinterpret_cast<const f32x4*>(vp + 4);
      kv = pack8(k0, k1); vv = pack8(v0, v1);
    } else if (p < 2056) {
      kv = *reinterpret_cast<const bf16x8*>(KB + (size_t)(NPR + bb * 8 + p - 2048) * 512 + h * 64 + seg * 8);
      vv = *reinterpret_cast<const bf16x8*>(VB + (size_t)(NPR + bb * 8 + p - 2048) * 512 + h * 64 + seg * 8);
    }
    R.k[i] = kv; R.v[i] = vv;
  }
}

__device__ __forceinline__ void attn_item(const Args& a, int item, unsigned char* lds) {
  float* St = (float*)lds;
  u16* Kc = (u16*)(lds + 69632);
  u16* Vr = (u16*)(lds + 69632 + 36864);
  const int tid = fresh_tid(), lane = tid & 63, w = tid >> 6, n = lane & 15, rg = lane >> 4;
  const bool samp = item >= 512;
  int bb, h, T0, nvalid, qrow0, krow0;
  if (!samp) { bb = item >> 7; h = (item >> 4) & 7; int sp = item & 15; T0 = sp * 256; nvalid = 256; qrow0 = bb * SEQ + T0; krow0 = bb * SEQ; }
  else { int s = item - 512; bb = s >> 3; h = s & 7; T0 = 2048; nvalid = 8; qrow0 = NPR + bb * 8; krow0 = 0; }
  const float slope = exp2f(-(float)(h + 1));
  const u16* QB = (const u16*)(a.ws + WS_QB);
  __syncthreads();
  for (int idx = tid; idx < 256 * 68; idx += NTHR) { int c = idx % 68; St[idx] = (c == 64) ? -1e30f : 0.f; }
  __syncthreads();
#pragma unroll 1
  for (int br = 0; br < 3; ++br) {
    const int d = (br == 0) ? 16 : (br == 1) ? 4 : 1;
    const int nq = 16 / d;
    const int nch = (br == 0) ? 9 : (br == 1) ? 3 : 2;
    const int nk = 256 / d;
    const int dsh = (br == 0) ? 4 : (br == 1) ? 2 : 0;
    int ur[2], uqt[2], utq[2]; bool uact[2];
    bf16x8 Qf[2][2]; f32x4 acc[2][4]; float mrun[2], lrun[2];
#pragma unroll
    for (int uu = 0; uu < 2; ++uu) {
      const int ui = 2 * w + uu;
      ur[uu] = ui / nq; uqt[uu] = ui % nq;
      utq[uu] = d * (16 * uqt[uu] + n) + ur[uu];
      uact[uu] = (d * 16 * uqt[uu] + ur[uu]) < nvalid;
      const bool qv = utq[uu] < nvalid;
#pragma unroll
      for (int s2 = 0; s2 < 2; ++s2) {
        bf16x8 q = (bf16x8){0, 0, 0, 0, 0, 0, 0, 0};
        if (qv) q = *reinterpret_cast<const bf16x8*>(QB + (size_t)(qrow0 + utq[uu]) * 512 + h * 64 + 32 * s2 + 8 * rg);
        Qf[uu][s2] = q;
      }
#pragma unroll
      for (int dt = 0; dt < 4; ++dt) acc[uu][dt] = *reinterpret_cast<const f32x4*>(St + utq[uu] * 68 + 16 * dt + 4 * rg);
      mrun[uu] = St[utq[uu] * 68 + 64];
      lrun[uu] = (rg == 0) ? St[utq[uu] * 68 + 65] : 0.f;
    }
    int ck = (nch - 1) - (T0 >> 8); if (ck < 0) ck = 0;
    KVRegs R;
    attn_fetch(a, R, samp, bb, h, krow0, T0 + 256 * (ck - (nch - 1)), tid, br);
#pragma unroll 1
    for (; ck < nch; ++ck) {
      __syncthreads();
#pragma unroll
      for (int i = 0; i < 4; ++i) {
        const int idx = tid + 512 * i; const int tl = idx >> 3, seg = idx & 7;
        const int kidx = (tl & (d - 1)) * nk + (tl >> dsh);
        *reinterpret_cast<bf16x8*>(Kc + kidx * 72 + seg * 8) = R.k[i];
        *reinterpret_cast<bf16x8*>(Vr + kidx * 72 + seg * 8) = R.v[i];
      }
      __syncthreads();
      if (ck + 1 < nch) attn_fetch(a, R, samp, bb, h, krow0, T0 + 256 * (ck + 1 - (nch - 1)), tid, br);
#pragma unroll
      for (int uu = 0; uu < 2; ++uu) {
        if (!uact[uu]) continue;
        const int r = ur[uu], qt = uqt[uu];
        for (int kt = 0; kt < nq; ++kt) {
          const int Dl = qt - kt - nq * (ck - (nch - 1));
          if (Dl < 0 || Dl > 8) continue;
          const int kbase = r * nk + 16 * kt;
          f32x4 s4 = (f32x4){0.f, 0.f, 0.f, 0.f};
#pragma unroll
          for (int s2 = 0; s2 < 2; ++s2) {
            bf16x8 ka = *reinterpret_cast<const bf16x8*>(Kc + (kbase + n) * 72 + 32 * s2 + 8 * rg);
            s4 = __builtin_amdgcn_mfma_f32_16x16x32_bf16(ka, Qf[uu][s2], s4, 0, 0, 0);
          }
          float sc[4]; bool vl[4]; float mloc = -1e30f;
#pragma unroll
          for (int jj = 0; jj < 4; ++jj) {
            const int j = 16 * Dl + n - (4 * rg + jj);
            vl[jj] = (j >= 0) && (j <= 128);
            sc[jj] = vl[jj] ? (s4[jj] * 0.125f - slope * (float)(j * d)) : -1e30f;
            mloc = fmaxf(mloc, sc[jj]);
          }
          mloc = fmaxf(mloc, __shfl_xor(mloc, 16));
          mloc = fmaxf(mloc, __shfl_xor(mloc, 32));
          const float mnew = fmaxf(mrun[uu], mloc);
          const float alpha = __expf(mrun[uu] - mnew);
          float p4[4]; float ps = 0.f;
#pragma unroll
          for (int jj = 0; jj < 4; ++jj) { p4[jj] = vl[jj] ? __expf(sc[jj] - mnew) : 0.f; ps += p4[jj]; }
          lrun[uu] = lrun[uu] * alpha + ps;
          mrun[uu] = mnew;
          bf16x4 pb;
          pb[0] = (short)f2bf(p4[0]); pb[1] = (short)f2bf(p4[1]); pb[2] = (short)f2bf(p4[2]); pb[3] = (short)f2bf(p4[3]);
#pragma unroll
          for (int dt = 0; dt < 4; ++dt) {
            bf16x4 va = __builtin_amdgcn_ds_read_tr16_b64_v4i16((AS3 bf16x4*)(Vr + (kbase + 4 * rg + (n >> 2)) * 72 + 16 * dt + 4 * (n & 3)));
            f32x4 t = acc[uu][dt] * alpha;
            acc[uu][dt] = __builtin_amdgcn_mfma_f32_16x16x16bf16_1k(va, pb, t, 0, 0, 0);
          }
        }
      }
    }
#pragma unroll
    for (int uu = 0; uu < 2; ++uu) {
      float lt = lrun[uu];
      lt += __shfl_xor(lt, 16); lt += __shfl_xor(lt, 32);
#pragma unroll
      for (int dt = 0; dt < 4; ++dt) *reinterpret_cast<f32x4*>(St + utq[uu] * 68 + 16 * dt + 4 * rg) = acc[uu][dt];
      if (rg == 0) { St[utq[uu] * 68 + 64] = mrun[uu]; St[utq[uu] * 68 + 65] = lt; }
    }
    __syncthreads();
  }
  {
    const int tq = tid >> 1, half = tid & 1;
    float v[32]; float ss = 0.f;
    const float linv = 1.f / St[tq * 68 + 65];
#pragma unroll
    for (int q = 0; q < 8; ++q) {
      f32x4 t4 = *reinterpret_cast<const f32x4*>(St + tq * 68 + 32 * half + 4 * q);
#pragma unroll
      for (int e = 0; e < 4; ++e) { float x = t4[e] * linv; v[4 * q + e] = x; ss += x * x; }
    }
    ss += __shfl_xor(ss, 1);
    const float rstd = rsqrtf(ss * (1.f / 64.f) + EPS);
    if (tq < nvalid) {
      u16* MIX = (u16*)(a.ws + WS_MIX);
      unsigned outp[16];
#pragma unroll
      for (int q = 0; q < 16; ++q) {
        float oa = v[2 * q] * rstd * a.in[12][32 * half + 2 * q];
        float ob = v[2 * q + 1] * rstd * a.in[12][32 * half + 2 * q + 1];
        outp[q] = pack2(oa, ob);
      }
      uint4* op = reinterpret_cast<uint4*>(MIX + (size_t)(qrow0 + tq) * DM + 512 + h * 64 + 32 * half);
#pragma unroll
      for (int q = 0; q < 4; ++q) op[q] = make_uint4(outp[4 * q], outp[4 * q + 1], outp[4 * q + 2], outp[4 * q + 3]);
    }
  }
  __syncthreads();
}

#define XB_TMO      128
#define XB_XCNT(j)  (256  + 64 * (j))
#define XB_XSUB(j)  (1280 + 64 * (j))
#define XB_XGEN(j)  (2304 + 64 * (j))
#define XB_TOP      3328
#define XB_TOPGEN   3392
#define XCD_BAR_WORDS 3456
#define XB_SPIN_CAP (1u << 20)
__device__ __forceinline__ unsigned xb_ld(unsigned* p)              { return __hip_atomic_load(p, __ATOMIC_RELAXED, __HIP_MEMORY_SCOPE_AGENT); }
__device__ __forceinline__ unsigned xb_add(unsigned* p, unsigned v) { return __hip_atomic_fetch_add(p, v, __ATOMIC_RELAXED, __HIP_MEMORY_SCOPE_AGENT); }
__device__ __forceinline__ unsigned xb_xcc_id() { return (unsigned)__builtin_amdgcn_s_getreg((3 << 11) | 20) & 0xFu; }
#define XB_SPIN(cond, bar) do { unsigned _sp = 0; while (cond) { __builtin_amdgcn_s_sleep(1); \
    if ((++_sp & 255u) == 0u) { if (xb_ld(&(bar)[XB_TMO])) break; if (_sp > XB_SPIN_CAP) { atomicAdd(&(bar)[XB_TMO], 1u); break; } } } } while (0)
struct XcdBarrier { unsigned* bar; unsigned x, nloc, nx; };
__device__ __forceinline__ void xcd_barrier_complete(unsigned* bar, unsigned x, unsigned& nloc, unsigned& nx) {
  const unsigned G = gridDim.x;
  unsigned sum, cnt, mine, sp = 0u;
  for (;;) {
    sum = 0u; cnt = 0u; mine = 0u;
#pragma unroll
    for (unsigned j = 0; j < 16; ++j) { const unsigned c = xb_ld(&bar[XB_XCNT(j)]); sum += c; cnt += (c > 0u) ? 1u : 0u; mine = (j == x) ? c : mine; }
    if (sum == G) break;
    __builtin_amdgcn_s_sleep(1);
    if ((++sp & 255u) == 0u) { if (xb_ld(&bar[XB_TMO])) break; if (sp > XB_SPIN_CAP) { atomicAdd(&bar[XB_TMO], 1u); break; } }
  }
  nloc = mine > 0u ? mine : 1u; nx = cnt > 0u ? cnt : 1u;
}
__device__ __forceinline__ void xcd_barrier(XcdBarrier& b) {
  asm volatile("s_waitcnt vmcnt(0)" ::: "memory");
  __syncthreads();
  if (threadIdx.x == 0) {
    unsigned* bar = b.bar;
    __builtin_amdgcn_s_waitcnt(0);
    unsigned nloc = b.nloc, nx = b.nx;
    if (nloc == 0u) { xcd_barrier_complete(bar, b.x, nloc, nx); }
    b.nloc = __builtin_amdgcn_readfirstlane(nloc); b.nx = __builtin_amdgcn_readfirstlane(nx);
    const unsigned old = xb_add(&bar[XB_XSUB(b.x)], 1u);
    const unsigned gen = old / nloc;
    if (old + 1u == (gen + 1u) * nloc) {
      __builtin_amdgcn_fence(__ATOMIC_RELEASE, "agent");
      asm volatile("s_waitcnt vmcnt(0)" ::: "memory");
      const unsigned og = xb_add(&bar[XB_TOP], 1u);
      const unsigned tg = og / nx;
      if (og + 1u == (tg + 1u) * nx) xb_add(&bar[XB_TOPGEN], 1u);
      else XB_SPIN(xb_ld(&bar[XB_TOPGEN]) == tg, bar);
      __builtin_amdgcn_fence(__ATOMIC_ACQUIRE, "agent");
      xb_add(&bar[XB_XGEN(b.x)], 1u);
      asm volatile("s_waitcnt vmcnt(0)" ::: "memory");
    } else {
      XB_SPIN(xb_ld(&bar[XB_XGEN(b.x)]) == gen, bar);
      __builtin_amdgcn_fence(__ATOMIC_ACQUIRE, "agent");
      asm volatile("s_waitcnt vmcnt(0)" ::: "memory");
    }
  }
  __syncthreads();
}

__device__ __forceinline__ bool tile_of(int round, int C, int& pm, int& pn, int& o) {
  const int b = blockIdx.x;
  o = (gridDim.x == 256) ? ((round * 8 + (b & 7)) * 32 + (b >> 3)) : (round * (int)gridDim.x + b);
  if (o >= 65 * C) return false;
  const int nfull = C >> 2;
  if (o < nfull * 260) { const int cg = o / 260, rem = o - cg * 260; pm = rem >> 2; pn = 4 * cg + (rem & 3); }
  else { const int rem = o - nfull * 260, w = C & 3; pm = rem / w; pn = 4 * nfull + (rem - pm * w); }
  return true;
}

__global__ void __launch_bounds__(NTHR) fwd_kernel(Args a) {
  extern __shared__ __attribute__((aligned(16))) unsigned char lds[];
  const int lo = a.ph_lo, hi = a.ph_hi;
  XcdBarrier xb; xb.bar = (unsigned*)(a.ws + WS_BAR); xb.x = xb_xcc_id(); xb.nloc = 0u; xb.nx = 0u;
  if (threadIdx.x == 0 && hi - lo > 1) (void)xb_add(&xb.bar[XB_XCNT(xb.x)], 1u);
  if (lo < 0) cg::this_grid().sync();
#ifndef PHM
#define PHM 0x1ff
#endif
#define IN(k) ((((PHM) >> (k)) & 1) && lo <= (k) && (k) < hi)
#ifndef REPM
#define REPM 0
#endif
#define NREP(k) ((((REPM) >> (k)) & 1) ? 2 : 1)
#define SEAM(k) do { if (IN(k) && IN((k) + 1)) { xcd_barrier(xb); } } while (0)
  if (IN(0)) for (int rep_ = 0; rep_ < NREP(0); ++rep_) { phase0(a, lds); }
  SEAM(0);
  if (IN(1)) for (int rep_ = 0; rep_ < NREP(1); ++rep_) {
    const u16* H = (const u16*)(a.ws + WS_H); const u16* W = (const u16*)(a.ws + WS_WIN);
    float* outp = a.out;
    int oslot = 0;
    for (int rnd = 0;; ++rnd) {
      int pm, pn; if (!tile_of(rnd, 15, pm, pn, oslot)) break;
      const int brow = pm * 256, bcol = pn * 256;
      if (pn < 6) {
        u16* dst = (u16*)(a.ws + WS_QKVA);
        gemm_tile(lds, H, W, DM, DM, brow, bcol, [=](f32x4 c0, f32x4 c1, int row0, int col0) {
          const unsigned o = (unsigned)row0 * 1536u + (unsigned)col0;
#pragma unroll
          for (int j = 0; j < 4; ++j) { dst[o + j * 1536] = f2bf(c0[j]); dst[o + j * 1536 + 16] = f2bf(c1[j]); }
          if (row0 < NPR) {
            if ((row0 & 4095) == 4092) {
              const unsigned oo = (unsigned)O_CONVP + (unsigned)((row0 >> 12) * 3) * 1536u + (unsigned)col0;
#pragma unroll
              for (int j = 1; j < 4; ++j) { outp[oo + (j - 1) * 1536] = c0[j]; outp[oo + (j - 1) * 1536 + 16] = c1[j]; }
            }
          } else if (((row0 - NPR) & 7) == 4) {
            const unsigned oo = (unsigned)O_CONVS + (unsigned)(((row0 - NPR) >> 3) * 3) * 1536u + (unsigned)col0;
#pragma unroll
            for (int j = 1; j < 4; ++j) { outp[oo + (j - 1) * 1536] = c0[j]; outp[oo + (j - 1) * 1536 + 16] = c1[j]; }
          }
        });
      } else if (pn < 10) {
        u16* dst = (u16*)(a.ws + (pn < 8 ? WS_Z : WS_QB));
        const int cbase = (pn < 8) ? 1536 : 2048;
        gemm_tile(lds, H, W, DM, DM, brow, bcol, [=](f32x4 c0, f32x4 c1, int row0, int col0) {
          const unsigned o = (unsigned)row0 * 512u + (unsigned)(col0 - cbase);
#pragma unroll
          for (int j = 0; j < 4; ++j) { dst[o + j * 512] = f2bf(c0[j]); dst[o + j * 512 + 16] = f2bf(c1[j]); }
        });
      } else if (pn < 14) {
        const bool isk = pn < 12;
        u16* dst = (u16*)(a.ws + (isk ? WS_KB : WS_VB));
        const int cbase = isk ? 2560 : 3072;
        const unsigned offp = (unsigned)(isk ? O_WKP : O_WVP), offs = (unsigned)(isk ? O_WKS : O_WVS);
        gemm_tile(lds, H, W, DM, DM, brow, bcol, [=](f32x4 c0, f32x4 c1, int row0, int col0) {
          const unsigned cl = (unsigned)(col0 - cbase);
          const unsigned o = (unsigned)row0 * 512u + cl;
#pragma unroll
          for (int j = 0; j < 4; ++j) { dst[o + j * 512] = f2bf(c0[j]); dst[o + j * 512 + 16] = f2bf(c1[j]); }
          if (row0 < NPR) {
            const int tt = row0 & 4095;
            if (tt >= 2048) {
              const unsigned oo = offp + ((unsigned)(row0 >> 12) * 2048u + (unsigned)(tt - 2048)) * 512u + cl;
#pragma unroll
              for (int j = 0; j < 4; ++j) { outp[oo + j * 512] = c0[j]; outp[oo + j * 512 + 16] = c1[j]; }
            }
          } else {
            const int r2 = row0 - NPR;
            const unsigned oo = offs + ((unsigned)(r2 >> 3) * 2048u + 2040u + (unsigned)(r2 & 7)) * 512u + cl;
#pragma unroll
            for (int j = 0; j < 4; ++j) { outp[oo + j * 512] = c0[j]; outp[oo + j * 512 + 16] = c1[j]; }
          }
        });
      } else {
        float* BETA = (float*)(a.ws + WS_BETA); float* Gd = (float*)(a.ws + WS_G);
        const float* alog = a.in[9]; const float* dtb = a.in[10];
        gemm_tile(lds, H, W, DM, DM, brow, bcol, [=](f32x4 c0, f32x4 c1, int row0, int col0) {
          const int cl = col0 - 3584;
          if (cl < 8) {
            const int hh = cl & 3;
#pragma unroll
            for (int j = 0; j < 4; ++j) {
              const int row = row0 + j;
              if (cl < 4) BETA[row * 4 + hh] = 1.f / (1.f + expf(-c0[j]));
              else { float xx = c0[j] + dtb[hh]; float sp = (xx > 20.f) ? xx : log1pf(expf(xx)); Gd[row * 4 + hh] = -expf(alog[hh]) * sp; }
            }
          }
        });
      }
    }
    if (gridDim.x == 256 && oslot >= 975 && oslot < 1024) copy_range(a, 0, 588, oslot - 975, 49, fresh_tid());
  }
  do { if (IN(1) && IN(3)) { xcd_barrier(xb); } } while (0);
  if (IN(3)) {
    int* qctr = (int*)(a.ws + WS_CTL + 6144);
    int* qslot = (int*)(lds + LDS_BYTES - 16);
    const bool ded = (gridDim.x == 256);
    if (ded && blockIdx.x < 16) gdn_scan_item(a, blockIdx.x, lds);
    else for (;;) {
      __syncthreads();
      if (threadIdx.x == 0) *qslot = __hip_atomic_fetch_add(qctr, 1, __ATOMIC_RELAXED, __HIP_MEMORY_SCOPE_AGENT);
      __syncthreads();
      const int q = *qslot;
      if (ded && q >= 2048) {
        const int ci = q - 2048;
        if (ci < 357) {
          const int j0 = 1224 + ci * 8, j1 = (j0 + 8 < 4080) ? j0 + 8 : 4080;
          copy_range(a, j0, j1, 0, 1, fresh_tid());
          continue;
        }
        const int ti = ci - 357;
        if (ti >= (J_T3 - J_T0) / 2) break;
        p0_transpose(a, J_T0 + 2 * ti, lds);
        p0_transpose(a, J_T0 + 2 * ti + 1, lds);
        continue;
      }
      if (q >= 2048 + (ded ? 0 : 16)) break;
      if (q < 1152) {
        const int item = (q < 1024) ? ((q & 15) * 64 + (q >> 4)) : q;
        gdn_prep_item(a, item, lds);
      } else if (q < 1664) attn_item(a, 511 - (q - 1152), lds);
      else if (q < 1920) attn_item(a, 512 + (q - 1664), lds);
      else if (q < 2048) gdn_scan_item(a, 16 + (q - 1920), lds);
      else gdn_scan_item(a, q - 2048, lds);
    }
  }
  SEAM(3);
  if (IN(4)) for (int rep_ = 0; rep_ < NREP(4); ++rep_) {
    const u16* MIX = (const u16*)(a.ws + WS_MIX); const u16* W = (const u16*)(a.ws + WS_WOUT);
    u16* X1B = (u16*)(a.ws + WS_X1);
    const float* xp = a.in[0]; const float* xs = a.in[1];
    const bool splitk = (gridDim.x == 256);
    int oslot = 0;
    for (int rnd = 0;; ++rnd) {
      int pm, pn; if (!tile_of(rnd, 4, pm, pn, oslot)) break;
      if (splitk && pm == 64) break;
      gemm_tile(lds, MIX, W, DM, DM, pm * 256, pn * 256, [=](f32x4 c0, f32x4 c1, int row0, int col0) {
#pragma unroll
        for (int j = 0; j < 4; ++j) {
          const unsigned o = (unsigned)(row0 + j) * 1024u + (unsigned)col0;
          const float* xb_ = (row0 < NPR) ? xp : (xs - (size_t)NPR * 1024);
          X1B[o] = f2bf(xb_[o] + c0[j]);
          X1B[o + 16] = f2bf(xb_[o + 16] + c1[j]);
        }
      });
    }
    if (splitk) {
      if (blockIdx.x < 16) {
        const int pn = blockIdx.x & 3, ks = blockIdx.x >> 2;
        float* PART = (float*)(a.ws + WS_PART4) + (size_t)ks * 256 * 1024;
        gemm_tile(lds, MIX + ks * 256, W + ks * 256, 256, DM, 64 * 256, pn * 256, [=](f32x4 c0, f32x4 c1, int row0, int col0) {
#pragma unroll
          for (int j = 0; j < 4; ++j) {
            const size_t o = (size_t)(row0 + j - NPR) * DM + col0;
            PART[o] = c0[j]; PART[o + 16] = c1[j];
          }
        });
      }
    } else { const int ctid = fresh_tid(); for (int jb = blockIdx.x; jb < 2300; jb += gridDim.x) copy_job(a, jb, ctid); }
  }
  SEAM(4);
  if (IN(5)) for (int rep_ = 0; rep_ < NREP(5); ++rep_) {
    const int wave = fresh_tid() >> 6;
    for (int job = blockIdx.x; job < 1040; job += gridDim.x) {
#pragma unroll
      for (int rr = 0; rr < 2; ++rr) {
        int row = job * 16 + wave * 2 + rr;
        u16* x1r = (u16*)(a.ws + WS_X1) + (size_t)row * DM;
        if (gridDim.x == 256 && row >= NPR) {
          const int ln = fresh_tid() & 63;
          const float* xr = a.in[1] + (size_t)(row - NPR) * DM;
          const float* pp = (const float*)(a.ws + WS_PART4) + (size_t)(row - NPR) * DM;
#pragma unroll
          for (int i = 0; i < 4; ++i) {
            f32x4 v = *reinterpret_cast<const f32x4*>(xr + (i * 64 + ln) * 4);
#pragma unroll
            for (int ks = 0; ks < 4; ++ks) v += *reinterpret_cast<const f32x4*>(pp + (size_t)ks * 256 * 1024 + (i * 64 + ln) * 4);
            uint2 pk; pk.x = pack2(v[0], v[1]); pk.y = pack2(v[2], v[3]);
            *reinterpret_cast<uint2*>(x1r + (i * 64 + ln) * 4) = pk;
          }
        }
        rms_row_b2b(x1r, a.in[14], (u16*)(a.ws + WS_H) + (size_t)row * DM);
      }
    }
  }
  SEAM(5);
  if (IN(6)) for (int rep_ = 0; rep_ < NREP(6); ++rep_) {
    const u16* H = (const u16*)(a.ws + WS_H); const u16* W = (const u16*)(a.ws + WS_WGU);
    u16* ACT = (u16*)(a.ws + WS_ACT);
    int oslot = 0;
    for (int rnd = 0;; ++rnd) {
      int pm, pn; if (!tile_of(rnd, 22, pm, pn, oslot)) break;
      const int bcol = pn * 256;
      gemm_tile(lds, H, W, DM, DM, pm * 256, bcol, [=](f32x4 c0, f32x4 c1, int row0, int col0) {
        const int cl = col0 - bcol; const int f = pn * 128 + (cl >> 7) * 64 + ((cl >> 5) & 3) * 16 + (cl & 15);
        const unsigned o = (unsigned)row0 * 2816u + (unsigned)f;
#pragma unroll
        for (int j = 0; j < 4; ++j) ACT[o + j * 2816] = f2bf(silu_f(c0[j]) * c1[j]);
      });
    }
    if (gridDim.x == 256 && oslot >= 1430 && oslot < 1536) copy_range(a, 588, 1224, oslot - 1430, 106, fresh_tid());
  }
  SEAM(6);
  if (IN(7)) for (int rep_ = 0; rep_ < NREP(7); ++rep_) {
    const u16* ACT = (const u16*)(a.ws + WS_ACT); const u16* W = (const u16*)(a.ws + WS_WD);
    const u16* X1B = (const u16*)(a.ws + WS_X1);
    u16* X2B = (u16*)(a.ws + WS_H);
    const bool splitk = (gridDim.x == 256);
    int oslot = 0;
    for (int rnd = 0;; ++rnd) {
      int pm, pn; if (!tile_of(rnd, 4, pm, pn, oslot)) break;
      if (splitk && pm == 64) break;
      gemm_tile(lds, ACT, W, DFF, DFF, pm * 256, pn * 256, [=](f32x4 c0, f32x4 c1, int row0, int col0) {
#pragma unroll
        for (int j = 0; j < 4; ++j) {
          const unsigned o = (unsigned)(row0 + j) * 1024u + (unsigned)col0;
          X2B[o] = f2bf(bf2f(X1B[o]) + c0[j]);
          X2B[o + 16] = f2bf(bf2f(X1B[o + 16]) + c1[j]);
        }
      });
    }
    if (splitk) {
      if (blockIdx.x < 44) {
        const int pn = blockIdx.x & 3, ks = blockIdx.x >> 2;
        float* PART = (float*)(a.ws + WS_PART7) + (size_t)ks * 256 * 1024;
        gemm_tile(lds, ACT + ks * 256, W + ks * 256, 256, DFF, 64 * 256, pn * 256, [=](f32x4 c0, f32x4 c1, int row0, int col0) {
#pragma unroll
          for (int j = 0; j < 4; ++j) {
            const size_t o = (size_t)(row0 + j - NPR) * DM + col0;
            PART[o] = c0[j]; PART[o + 16] = c1[j];
          }
        });
      }
    } else { const int ctid = fresh_tid(); for (int jb = 2300 + blockIdx.x; jb < 4080; jb += gridDim.x) copy_job(a, jb, ctid); }
  }
  SEAM(7);
  if (IN(8)) for (int rep_ = 0; rep_ < NREP(8); ++rep_) {
    const int tid = fresh_tid(), lane = tid & 63, wave = tid >> 6;
    for (int job = blockIdx.x; job < 1040; job += gridDim.x) {
      float* yr0 = a.out + (size_t)(job * 16 + wave * 2) * DM;
      f32x4 x[2][4]; float ss[2] = {0.f, 0.f};
#pragma unroll
      for (int rr = 0; rr < 2; ++rr) {
        const int row = job * 16 + wave * 2 + rr;
        if (gridDim.x == 256 && row >= NPR) {
          const u16* x1r = (const u16*)(a.ws + WS_X1) + (size_t)row * DM;
          const float* pp = (const float*)(a.ws + WS_PART7) + (size_t)(row - NPR) * DM;
#pragma unroll
          for (int i = 0; i < 4; ++i) {
            const uint2 u1 = *reinterpret_cast<const uint2*>(x1r + (i * 64 + lane) * 4);
            f32x4 v = (f32x4){bflo(u1.x), bfhi(u1.x), bflo(u1.y), bfhi(u1.y)};
#pragma unroll
            for (int ks = 0; ks < 11; ++ks) v += *reinterpret_cast<const f32x4*>(pp + (size_t)ks * 256 * 1024 + (i * 64 + lane) * 4);
            x[rr][i] = v;
          }
        } else {
          const u16* xb = (const u16*)(a.ws + WS_H) + (size_t)row * DM;
#pragma unroll
          for (int i = 0; i < 4; ++i) {
            const uint2 u = *reinterpret_cast<const uint2*>(xb + (i * 64 + lane) * 4);
            x[rr][i] = (f32x4){bflo(u.x), bfhi(u.x), bflo(u.y), bfhi(u.y)};
          }
        }
      }
#pragma unroll
      for (int rr = 0; rr < 2; ++rr) {
#pragma unroll
        for (int i = 0; i < 4; ++i) ss[rr] += x[rr][i][0] * x[rr][i][0] + x[rr][i][1] * x[rr][i][1] + x[rr][i][2] * x[rr][i][2] + x[rr][i][3] * x[rr][i][3];
        ss[rr] = wave_sum(ss[rr]);
      }
#pragma unroll
      for (int rr = 0; rr < 2; ++rr) {
        const float rstd = rsqrtf(ss[rr] * (1.f / 1024.f) + EPS);
#pragma unroll
        for (int i = 0; i < 4; ++i) {
          f32x4 wv = *reinterpret_cast<const f32x4*>(a.in[18] + (i * 64 + lane) * 4);
          f32x4 y;
          y[0] = x[rr][i][0] * rstd * wv[0]; y[1] = x[rr][i][1] * rstd * wv[1]; y[2] = x[rr][i][2] * rstd * wv[2]; y[3] = x[rr][i][3] * rstd * wv[3];
          *reinterpret_cast<f32x4*>(yr0 + rr * DM + (i * 64 + lane) * 4) = y;
        }
      }
    }
  }
#undef IN
#undef SEAM
}

extern "C" void kernel_launch(void* const* d_in, const int* in_sizes, int n_in, void* d_out, int out_size,
                              void* d_ws, size_t ws_size, hipStream_t stream) {
  static int grid = 0;
  if (grid == 0) {
    if (n_in != 19 || (size_t)out_size != O_END || ws_size < WS_END) {
      fprintf(stderr, "kernel_launch: unexpected shapes n_in %d out %d ws %zu (need %zu)\n", n_in, out_size, ws_size, (size_t)WS_END);
      grid = -1; return;
    }
    int dev = 0, cus = 0, per_cu = 0;
    hipGetDevice(&dev);
    hipDeviceGetAttribute(&cus, hipDeviceAttributeMultiprocessorCount, dev);
    if (hipFuncSetAttribute((const void*)fwd_kernel, hipFuncAttributeMaxDynamicSharedMemorySize, LDS_BYTES) != hipSuccess) {
      fprintf(stderr, "kernel_launch: hipFuncSetAttribute failed\n"); grid = -1; return;
    }
    hipOccupancyMaxActiveBlocksPerMultiprocessor(&per_cu, (const void*)fwd_kernel, NTHR, LDS_BYTES);
    if (per_cu < 1) per_cu = 1;
    grid = cus * per_cu;
    (void)hipGetLastError();
  }
  if (grid < 0) return;
  if (hipMemsetAsync((char*)d_ws + WS_CTL, 0, 32768, stream) != hipSuccess) { fprintf(stderr, "kernel_launch: memset of the ready flags failed\n"); return; }
  Args a{};
  for (int i = 0; i < 19; ++i) a.in[i] = (const float*)d_in[i];
  a.out = (float*)d_out; a.ws = (unsigned char*)d_ws;
#if ONE_LAUNCH
  a.ph_lo = 0; a.ph_hi = 9;
  void* args[] = {&a};
  hipError_t e = hipLaunchCooperativeKernel((const void*)fwd_kernel, dim3(grid), dim3(NTHR), args, LDS_BYTES, stream);
  if (e != hipSuccess) fprintf(stderr, "cooperative launch failed: %s (grid %d)\n", hipGetErrorString(e), grid);
#else
  for (int p = 0; p < 9; ++p) {
    if (p == 2) continue;
    a.ph_lo = p; a.ph_hi = p + 1;
    hipLaunchKernelGGL(fwd_kernel, dim3(grid), dim3(NTHR), LDS_BYTES, stream, a);
  }
#endif
}
```
